# Optimizing an MI355X kernel written in HIP

```python
import math
import jax, jax.numpy as jnp
from jax import lax
import numpy as np

D_MODEL = 2048
BATCH = 4
SEQ = 4096
DEPTH = 1

S5_WIDTH = D_MODEL // 2
S5_GROUP = 16
S5_GROUPS = S5_WIDTH // S5_GROUP
S5_STATE = 64
DT_MIN = 1e-3
DT_MAX = 1e-1
RET_HEADS = 4
RET_QK_DIM = D_MODEL // 8
RET_V_DIM = 2 * RET_QK_DIM
RET_QK_WIDTH = RET_HEADS * RET_QK_DIM
RET_V_WIDTH = RET_HEADS * RET_V_DIM
RET_CHUNK = 128
ROPE_BASE = 10000.0
MEM_LEN = 256
XATTN_HEADS = 4
XATTN_HEAD_DIM = D_MODEL // XATTN_HEADS
D_FF = 256 * ((8 * D_MODEL // 3 + 255) // 256)
N_IN = S5_WIDTH + 2 * RET_QK_WIDTH + 2 * RET_V_WIDTH + 2 * D_MODEL
RMS_EPS = 1e-6
GN_EPS = 1e-5

kernel_name = "hybrid_s5_retention_gated_macaron"


def rms_norm(x, g):
    xf = x.astype(jnp.float32)
    y = xf * lax.rsqrt(jnp.mean(xf * xf, axis=-1, keepdims=True) + RMS_EPS)
    return (y * g.astype(jnp.float32)).astype(x.dtype)


def swiglu(h, w1, w3, w2):
    return (jax.nn.silu(h @ w1) * (h @ w3)) @ w2


def _complex_affine_combine(e1, e2):
    a1r, a1i, b1r, b1i = e1
    a2r, a2i, b2r, b2i = e2
    return (a2r * a1r - a2i * a1i,
            a2r * a1i + a2i * a1r,
            a2r * b1r - a2i * b1i + b2r,
            a2r * b1i + a2i * b1r + b2i)


def s5_branch(u, a_re, a_im, log_dt, b_re, b_im, c_re, c_im, d_skip, w_v, w_g):
    f32 = jnp.float32
    bsz, seq, _ = u.shape
    uf = u.astype(f32)
    ug = uf.reshape(bsz, seq, S5_GROUPS, S5_GROUP)
    dt = jnp.exp(log_dt.astype(f32))[:, None]
    ar = a_re.astype(f32)
    ai = a_im.astype(f32)
    mag = jnp.exp(ar * dt)
    lbar_re = mag * jnp.cos(ai * dt)
    lbar_im = mag * jnp.sin(ai * dt)
    den = ar * ar + ai * ai
    nr = lbar_re - 1.0
    ni = lbar_im
    f_re = (nr * ar + ni * ai) / den
    f_im = (ni * ar - nr * ai) / den
    br = b_re.astype(f32)
    bi = b_im.astype(f32)
    bbar_re = f_re[..., None] * br - f_im[..., None] * bi
    bbar_im = f_re[..., None] * bi + f_im[..., None] * br
    bu_re = jnp.einsum('blgc,gpc->blgp', ug, bbar_re)
    bu_im = jnp.einsum('blgc,gpc->blgp', ug, bbar_im)
    a_t_re = jnp.broadcast_to(lbar_re, bu_re.shape)
    a_t_im = jnp.broadcast_to(lbar_im, bu_im.shape)
    _, _, s_re, s_im = lax.associative_scan(
        _complex_affine_combine, (a_t_re, a_t_im, bu_re, bu_im), axis=1)
    y = (jnp.einsum('blgp,gcp->blgc', s_re, c_re.astype(f32))
         - jnp.einsum('blgp,gcp->blgc', s_im, c_im.astype(f32)))
    y = y.reshape(bsz, seq, S5_WIDTH) + d_skip.astype(f32) * uf
    y = jax.nn.gelu(y).astype(u.dtype)
    return (y @ w_v) * jax.nn.sigmoid(y @ w_g)


def rotary(t):
    seq, d = t.shape[1], t.shape[-1]
    inv = ROPE_BASE ** (-jnp.arange(0, d, 2, dtype=jnp.float32) / d)
    ang = jnp.arange(seq, dtype=jnp.float32)[:, None] * inv[None, :]
    cos = jnp.cos(ang)[None, :, None, :]
    sin = jnp.sin(ang)[None, :, None, :]
    t1, t2 = t[..., : d // 2], t[..., d // 2:]
    return jnp.concatenate([t1 * cos - t2 * sin, t1 * sin + t2 * cos], axis=-1)


def retention_branch(q, k, v, g, w_o):
    f32 = jnp.float32
    bsz, seq, _ = q.shape
    n_chunks = seq // RET_CHUNK
    q = rotary(q.astype(f32).reshape(bsz, seq, RET_HEADS, RET_QK_DIM))
    k = rotary(k.astype(f32).reshape(bsz, seq, RET_HEADS, RET_QK_DIM)) * (RET_QK_DIM ** -0.5)
    v = v.astype(f32).reshape(bsz, seq, RET_HEADS, RET_V_DIM)

    def to_chunks(t):
        return t.reshape(bsz, n_chunks, RET_CHUNK, RET_HEADS, t.shape[-1]).transpose(1, 0, 3, 2, 4)

    log_gamma = jnp.log(1.0 - 2.0 ** (-5.0 - jnp.arange(RET_HEADS, dtype=f32)))
    idx = jnp.arange(RET_CHUNK, dtype=f32)
    rel = idx[:, None] - idx[None, :]
    decay_inner = jnp.where(rel[None] >= 0,
                            jnp.exp(jnp.maximum(rel, 0.0)[None] * log_gamma[:, None, None]), 0.0)
    xi = jnp.exp((idx + 1.0)[None, :] * log_gamma[:, None])[None, :, :, None]
    zeta = jnp.exp((RET_CHUNK - 1.0 - idx)[None, :] * log_gamma[:, None])[None, :, :, None]
    gamma_c = jnp.exp(RET_CHUNK * log_gamma)[None, :, None, None]

    def step(state, qkv):
        qc, kc, vc = qkv
        scores = jnp.einsum('bhid,bhjd->bhij', qc, kc) * decay_inner
        out = (jnp.einsum('bhij,bhje->bhie', scores, vc)
               + jnp.einsum('bhid,bhde->bhie', qc, state) * xi)
        state = state * gamma_c + jnp.einsum('bhjd,bhje->bhde', kc * zeta, vc)
        return state, out

    state0 = jnp.zeros((bsz, RET_HEADS, RET_QK_DIM, RET_V_DIM), f32)
    _, o = lax.scan(step, state0, (to_chunks(q), to_chunks(k), to_chunks(v)))
    o = o.transpose(1, 0, 3, 2, 4).reshape(bsz, seq, RET_HEADS, RET_V_DIM)
    mean = jnp.mean(o, axis=-1, keepdims=True)
    var = jnp.mean(jnp.square(o - mean), axis=-1, keepdims=True)
    o = ((o - mean) * lax.rsqrt(var + GN_EPS)).reshape(bsz, seq, RET_V_WIDTH)
    o = (jax.nn.silu(g.astype(f32)) * o).astype(g.dtype)
    return o @ w_o


def cross_attention(h, m, wq, wk, wv, wo):
    bsz, seq, _ = h.shape
    mlen = m.shape[1]
    q = (h @ wq).reshape(bsz, seq, XATTN_HEADS, XATTN_HEAD_DIM).astype(jnp.float32)
    k = (m @ wk).reshape(bsz, mlen, XATTN_HEADS, XATTN_HEAD_DIM).astype(jnp.float32)
    v = (m @ wv).reshape(bsz, mlen, XATTN_HEADS, XATTN_HEAD_DIM).astype(jnp.float32)
    s = jnp.einsum('blhd,bmhd->bhlm', q, k) * (XATTN_HEAD_DIM ** -0.5)
    p = jax.nn.softmax(s, axis=-1)
    o = jnp.einsum('bhlm,bmhd->blhd', p, v).reshape(bsz, seq, D_MODEL).astype(h.dtype)
    return o @ wo


def setup_inputs(seed: int = 0) -> dict:
    key = jax.random.key(seed)
    ks = iter(jax.random.split(key, 40))
    f32 = jnp.float32

    def dense(shape, fan_in):
        return jax.random.normal(next(ks), shape, f32) * (fan_in ** -0.5)

    def gain(shape):
        return 1.0 + 0.02 * jax.random.normal(next(ks), shape, f32)

    L = DEPTH
    n_idx = jnp.arange(S5_STATE, dtype=f32)
    a_re = -0.5 + 0.01 * jax.random.normal(next(ks), (L, S5_GROUPS, S5_STATE), f32)
    a_im = jnp.pi * n_idx[None, None, :] + 0.01 * jax.random.normal(next(ks), (L, S5_GROUPS, S5_STATE), f32)
    log_dt = jax.random.uniform(next(ks), (L, S5_GROUPS), f32, math.log(DT_MIN), math.log(DT_MAX))
    return {
        "x": jax.random.normal(next(ks), (BATCH, SEQ, D_MODEL), f32),
        "mem": jax.random.normal(next(ks), (BATCH, MEM_LEN, D_MODEL), f32),
        "ffn1_norm": gain((L, D_MODEL)),
        "ffn1_w1": dense((L, D_MODEL, D_FF), D_MODEL),
        "ffn1_w3": dense((L, D_MODEL, D_FF), D_MODEL),
        "ffn1_w2": dense((L, D_FF, D_MODEL), D_FF),
        "mix_norm": gain((L, D_MODEL)),
        "w_in": dense((L, D_MODEL, N_IN), D_MODEL),
        "s5_a_re": a_re,
        "s5_a_im": a_im,
        "s5_log_dt": log_dt,
        "s5_b_re": dense((L, S5_GROUPS, S5_STATE, S5_GROUP), 2 * S5_GROUP),
        "s5_b_im": dense((L, S5_GROUPS, S5_STATE, S5_GROUP), 2 * S5_GROUP),
        "s5_c_re": dense((L, S5_GROUPS, S5_GROUP, S5_STATE), S5_STATE / 4.0),
        "s5_c_im": dense((L, S5_GROUPS, S5_GROUP, S5_STATE), S5_STATE / 4.0),
        "s5_d": jax.random.normal(next(ks), (L, S5_WIDTH), f32),
        "s5_glu_v": dense((L, S5_WIDTH, D_MODEL), S5_WIDTH),
        "s5_glu_g": dense((L, S5_WIDTH, D_MODEL), S5_WIDTH),
        "ret_w_o": dense((L, RET_V_WIDTH, D_MODEL), RET_V_WIDTH),
        "w_out": dense((L, D_MODEL, D_MODEL), D_MODEL),
        "xattn_norm": gain((L, D_MODEL)),
        "mem_norm": gain((L, D_MODEL)),
        "xattn_wq": dense((L, D_MODEL, D_MODEL), D_MODEL),
        "xattn_wk": dense((L, D_MODEL, D_MODEL), D_MODEL),
        "xattn_wv": dense((L, D_MODEL, D_MODEL), D_MODEL),
        "xattn_wo": dense((L, D_MODEL, D_MODEL), D_MODEL),
        "ffn2_norm": gain((L, D_MODEL)),
        "ffn2_w1": dense((L, D_MODEL, D_FF), D_MODEL),
        "ffn2_w3": dense((L, D_MODEL, D_FF), D_MODEL),
        "ffn2_w2": dense((L, D_FF, D_MODEL), D_FF),
        "final_norm": gain((D_MODEL,)),
    }


def reference(x, mem, ffn1_norm, ffn1_w1, ffn1_w3, ffn1_w2, mix_norm, w_in,
              s5_a_re, s5_a_im, s5_log_dt, s5_b_re, s5_b_im, s5_c_re, s5_c_im, s5_d,
              s5_glu_v, s5_glu_g, ret_w_o, w_out, xattn_norm, mem_norm,
              xattn_wq, xattn_wk, xattn_wv, xattn_wo,
              ffn2_norm, ffn2_w1, ffn2_w3, ffn2_w2, final_norm):
    splits = np.cumsum([S5_WIDTH, RET_QK_WIDTH, RET_QK_WIDTH, RET_V_WIDTH, RET_V_WIDTH, D_MODEL])
    h = x
    for l in range(DEPTH):
        h = h + 0.5 * swiglu(rms_norm(h, ffn1_norm[l]), ffn1_w1[l], ffn1_w3[l], ffn1_w2[l])
        u = rms_norm(h, mix_norm[l])
        proj = u @ w_in[l]
        u_s5, q, k, v, g_ret, gate_a, gate_b = jnp.split(proj, splits, axis=-1)
        y_a = s5_branch(u_s5, s5_a_re[l], s5_a_im[l], s5_log_dt[l], s5_b_re[l], s5_b_im[l],
                        s5_c_re[l], s5_c_im[l], s5_d[l], s5_glu_v[l], s5_glu_g[l])
        y_b = retention_branch(q, k, v, g_ret, ret_w_o[l])
        merged = jax.nn.sigmoid(gate_a) * y_a + jax.nn.sigmoid(gate_b) * y_b
        h = h + merged @ w_out[l]
        h = h + cross_attention(rms_norm(h, xattn_norm[l]), rms_norm(mem, mem_norm[l]),
                                xattn_wq[l], xattn_wk[l], xattn_wv[l], xattn_wo[l])
        h = h + 0.5 * swiglu(rms_norm(h, ffn2_norm[l]), ffn2_w1[l], ffn2_w3[l], ffn2_w2[l])
    return rms_norm(h, final_norm)
```

```cpp
#include <hip/hip_runtime.h>
#include <hip/hip_cooperative_groups.h>
#include <cstdio>
#include <cstdint>
namespace cg = cooperative_groups;

#define LAS __attribute__((address_space(3)))
typedef unsigned short bf16_t;
typedef short bf16x8 __attribute__((ext_vector_type(8)));
typedef float f32x4 __attribute__((ext_vector_type(4)));
typedef unsigned u32x4 __attribute__((ext_vector_type(4)));
typedef unsigned u32x2 __attribute__((ext_vector_type(2)));

constexpr int DM = 2048, NB = 4, SEQ = 4096, T = NB * SEQ, FF = 5632, NIN = 11264, MEML = 256;
constexpr int NTHR = 512, NWAVE = 8;
constexpr int LDS_XB = 133120;
constexpr int LDS_BYTES = 133120 + 64;
constexpr float LG0 = -0.04580368961312479f, LG1 = -0.02272007650008353f, LG2 = -0.011315313227834146f, LG3 = -0.005646563141142063f;
__device__ __forceinline__ float lgam(int h) { return h == 0 ? LG0 : (h == 1 ? LG1 : (h == 2 ? LG2 : LG3)); }

constexpr size_t MiB = 1048576;
constexpr size_t WS_W13 = 0, WS_W2 = 44 * MiB, WS_WIN = 66 * MiB, WS_WGLU = 110 * MiB, WS_WORET = 118 * MiB, WS_WOUT = 126 * MiB, WS_WQ = 134 * MiB, WS_WXO = 142 * MiB;
constexpr size_t WS_HB = 150 * MiB;
constexpr size_t WS_SMALL = 214 * MiB;
constexpr size_t WS_RSTD = WS_SMALL;
constexpr size_t WS_PSS = WS_SMALL + 1 * MiB;
constexpr size_t WS_ROPE = WS_SMALL + 3 * MiB;
constexpr size_t WS_BT2 = WS_SMALL + 11 * MiB;
constexpr size_t WS_MB = WS_SMALL + 23 * MiB;
constexpr size_t WS_L16 = WS_SMALL + 28 * MiB;
constexpr size_t WS_GNS = WS_SMALL + 29 * MiB;
constexpr size_t WS_BAR = WS_SMALL + 29 * MiB + 768 * 1024;
constexpr size_t WS_MEMN = WS_SMALL + 30 * MiB;
constexpr size_t WS_KM = WS_SMALL + 34 * MiB;
constexpr size_t WS_VT = WS_SMALL + 38 * MiB;
constexpr size_t WS_MID = 256 * MiB;
constexpr size_t WS_ACT = WS_MID;
constexpr size_t WS_WK = WS_MID + 176 * MiB, WS_WV = WS_MID + 184 * MiB;
constexpr size_t WS_U2 = WS_MID;
constexpr size_t WS_ACAT = WS_MID + 48 * MiB;
constexpr size_t WS_K = WS_MID + 112 * MiB;
constexpr size_t WS_KZT = WS_MID + 144 * MiB;
constexpr size_t WS_BCAT = WS_MID + 176 * MiB;
constexpr size_t WS_O = WS_K;
constexpr size_t WS_YA = WS_ACAT;
constexpr size_t WS_YB = WS_BCAT;
constexpr size_t WS_XL = WS_W13;
constexpr size_t WS_YACT = WS_W13;
constexpr size_t WS_XQ = WS_BCAT;
constexpr size_t WS_SC = WS_BCAT + 64 * MiB;
constexpr size_t WS_P = WS_MID;
constexpr size_t WS_XO = WS_K;
constexpr size_t WS_GNP = WS_MID + 304 * MiB;
constexpr size_t WS_END = WS_MID + 308 * MiB;

struct Params {
    const float* in[31];
    float* out;
    unsigned char* ws;
};
enum { I_X = 0, I_MEM, I_FFN1N, I_F1W1, I_F1W3, I_F1W2, I_MIXN, I_WIN, I_ARE, I_AIM, I_LDT, I_BRE, I_BIM, I_CRE, I_CIM, I_S5D, I_GLUV, I_GLUG, I_RETWO, I_WOUT,
       I_XN, I_MEMNRM, I_XWQ, I_XWK, I_XWV, I_XWO, I_FFN2N, I_F2W1, I_F2W3, I_F2W2, I_FINALN };

__device__ __forceinline__ unsigned pk2(float lo, float hi) { unsigned r; asm("v_cvt_pk_bf16_f32 %0, %1, %2" : "=v"(r) : "v"(lo), "v"(hi)); return r; }
__device__ __forceinline__ float bflo(unsigned w) { return __uint_as_float(w << 16); }
__device__ __forceinline__ float bfhi(unsigned w) { return __uint_as_float(w & 0xffff0000u); }
__device__ __forceinline__ float sigm(float v) { return __builtin_amdgcn_rcpf(1.0f + __expf(-v)); }
__device__ __forceinline__ float wave_sum(float v) {
#pragma unroll
    for (int o = 1; o < 64; o <<= 1) v += __shfl_xor(v, o);
    return v;
}
__device__ __forceinline__ float wave_max(float v) {
#pragma unroll
    for (int o = 1; o < 64; o <<= 1) v = fmaxf(v, __shfl_xor(v, o));
    return v;
}
__device__ __forceinline__ u32x4 pk8(const f32x4 a, const f32x4 b) { u32x4 w; w.x = pk2(a[0], a[1]); w.y = pk2(a[2], a[3]); w.z = pk2(b[0], b[1]); w.w = pk2(b[2], b[3]); return w; }
__device__ __forceinline__ void unpk8(const u32x4 w, f32x4& a, f32x4& b) { a = (f32x4){bflo(w.x), bfhi(w.x), bflo(w.y), bfhi(w.y)}; b = (f32x4){bflo(w.z), bfhi(w.z), bflo(w.w), bfhi(w.w)}; }

constexpr int BM = 256, BK = 64, HALF = 128, HTB = HALF * BK * 2;
__device__ __forceinline__ int lds_byte(int r, int c) { const int st = (r >> 4) * 2 + (c >> 5), rr = r & 15, cc = c & 31, ob = rr * 64 + cc * 2; return st * 1024 + (ob ^ (((ob >> 9) & 1) << 5)); }
__device__ __forceinline__ void stage_rc(int b, int& R, int& C) { const int st = b / 1024, sb = b % 1024, swz = sb ^ (((sb >> 9) & 1) << 5); R = (st >> 1) * 16 + swz / 64; C = (st & 1) * 32 + (swz % 64) / 2; }
__device__ __forceinline__ int perm32(int rho) { const int n = rho >> 4, i = rho & 15; return 8 * (i >> 2) + 4 * n + (i & 3); }

struct Unit { int x, y, z; };
typedef f32x4 Acc[2][2][4][2];

__device__ __forceinline__ void tile_map(int L, int nM, int nN, int& pm, int& pn) {
    const int nwg = nM * nN; int wgid = L;
    { const int q = nwg >> 3, r = nwg & 7, xcd = wgid & 7, off = wgid >> 3; wgid = (xcd < r ? xcd * (q + 1) : r * (q + 1) + (xcd - r) * q) + off; }
    const int nig = 8 * nN, gid = wgid / nig, fm = gid * 8, gsz = (nM - fm) < 8 ? (nM - fm) : 8;
    pm = fm + ((wgid % nig) % gsz); pn = (wgid % nig) / gsz;
}

template <class Job> struct job_drain { static constexpr bool v = false; };
template <class Job>
__device__ __forceinline__ void gemm_phase(LAS unsigned char* lds, const Job& J, const bool rev0 = false) {
    const int tid = threadIdx.x, wid = __builtin_amdgcn_readfirstlane(tid >> 6), lane = tid & 63, wr = wid >> 2, wc = wid & 3, fr = lane & 15, fq = lane >> 4;
    const int nt = J.nt;
    const int G = gridDim.x, cblk = blockIdx.x;
    if (cblk >= J.nunits) return;
    unsigned voffA[2], voffB[2];
#pragma unroll
    for (int i = 0; i < 2; ++i) { int R, C; stage_rc(tid * 16 + i * 8192, R, C); const int Rb = (R & ~31) + perm32(R & 31);
        voffA[i] = (unsigned)(R * J.lda + C) * 2u; voffB[i] = (unsigned)(Rb * J.ldb + C) * 2u; }
    const long kfwd = (long)(BK * 2);
    long ks = rev0 ? -kfwd : kfwd;
    const size_t hstepA = (size_t)HALF * J.lda * 2, hstepB = (size_t)HALF * J.ldb * 2;
    const unsigned ldsw = (unsigned)wid * 1024u;
    const int aoff = lds_byte(wr * 64 + fr, fq * 8), boff = lds_byte(wc * 32 + fr, fq * 8);
#define PG8_SA(b, h) (((b) * 2 + (h)) * HTB)
#define PG8_SB(b, h) ((4 + (b) * 2 + (h)) * HTB)
#define PG8_STAGE(bufoff, gbase, voff) do { _Pragma("unroll") for (int _i = 0; _i < 2; ++_i) \
        __builtin_amdgcn_global_load_lds((const unsigned*)((const char*)(gbase) + (voff)[_i]), (LAS unsigned*)(lds + (bufoff) + ldsw + _i * 8192), 16, 0, 0); } while (0)
#define PG8_LDA(dst, b, h) do { _Pragma("unroll") for (int m = 0; m < 4; ++m) _Pragma("unroll") for (int k = 0; k < 2; ++k) dst[m][k] = *(const LAS bf16x8*)(lds + PG8_SA(b, h) + aoff + m * 2048 + k * 1024); } while (0)
#define PG8_LDB(dst, b, h) do { _Pragma("unroll") for (int n = 0; n < 2; ++n) _Pragma("unroll") for (int k = 0; k < 2; ++k) dst[n][k] = *(const LAS bf16x8*)(lds + PG8_SB(b, h) + boff + n * 2048 + k * 1024); } while (0)
#define PG8_MMA(ai, bj, At, Bt) do { __builtin_amdgcn_s_setprio(1); _Pragma("unroll") for (int m = 0; m < 4; ++m) _Pragma("unroll") for (int n = 0; n < 2; ++n) _Pragma("unroll") for (int k = 0; k < 2; ++k) \
        acc[ai][bj][m][n] = __builtin_amdgcn_mfma_f32_16x16x32_bf16(Bt[n][k], At[m][k], acc[ai][bj][m][n], 0, 0, 0); __builtin_amdgcn_s_setprio(0); } while (0)
#define PG8_WAIT_V(n) asm volatile("s_waitcnt vmcnt(" #n ")" ::: "memory")
#define PG8_WAIT_L(n) asm volatile("s_waitcnt lgkmcnt(" #n ")" ::: "memory")
#define PG8_BAR __builtin_amdgcn_s_barrier()
#define PG8_SCHED __builtin_amdgcn_sched_barrier(0)
    Unit cur, nxt; int ui = 0;
    const char* cA; const char* cB;
    J.get(cblk, cur, cA, cB);
    Acc acc;
#pragma unroll
    for (int a = 0; a < 2; ++a)
#pragma unroll
        for (int b = 0; b < 2; ++b)
#pragma unroll
            for (int m = 0; m < 4; ++m)
#pragma unroll
                for (int n = 0; n < 2; ++n) acc[a][b][m][n] = (f32x4){0.f, 0.f, 0.f, 0.f};
    bf16x8 At[4][2], B0[2][2], B1[2][2];
    if (rev0) { cA += (long)(nt - 1) * kfwd; cB += (long)(nt - 1) * kfwd; }
    PG8_STAGE(PG8_SB(0, 0), cB, voffB); PG8_STAGE(PG8_SB(0, 1), cB + hstepB, voffB); PG8_STAGE(PG8_SA(0, 0), cA, voffA); PG8_STAGE(PG8_SA(0, 1), cA + hstepA, voffA);
    if (wr == 1) PG8_BAR;
    PG8_WAIT_V(2); PG8_BAR;
    PG8_STAGE(PG8_SB(1, 0), cB + ks, voffB); PG8_STAGE(PG8_SA(1, 0), cA + ks, voffA); PG8_STAGE(PG8_SB(1, 1), cB + hstepB + ks, voffB);
    PG8_WAIT_V(6); PG8_BAR;
    for (;;) {
        const int Ln = (ui + 1) * G + cblk;
        const bool has_next = Ln < J.nunits;
        const char* nA; const char* nB; long ksN = ks;
        if (has_next) { J.get(Ln, nxt, nA, nB); ksN = -ks; if (ksN < 0) { nA += (long)(nt - 1) * kfwd; nB += (long)(nt - 1) * kfwd; } }
        else { nA = cA + (long)(nt - 2) * ks; nB = cB + (long)(nt - 2) * ks; }
        const char* pA = cA; const char* pB = cB;
        for (int t = 0; t < nt; t += 2) {
            const bool last = (t == nt - 2);
            const char* a1 = pA + ks;
            const char* a2 = last ? nA : pA + 2 * ks; const char* b2 = last ? nB : pB + 2 * ks;
            const long ks23 = last ? ksN : ks;
            const char* a3 = a2 + ks23; const char* b3 = b2 + ks23;
            pA += 2 * ks; pB += 2 * ks;
            PG8_LDB(B0, 0, 0); PG8_LDB(B1, 0, 1); PG8_SCHED; PG8_LDA(At, 0, 0); PG8_STAGE(PG8_SA(1, 1), a1 + hstepA, voffA);
            PG8_WAIT_V(8); PG8_WAIT_L(0); PG8_BAR; PG8_MMA(0, 0, At, B0); PG8_MMA(0, 1, At, B1); PG8_BAR; PG8_SCHED;
            PG8_LDA(At, 0, 1); PG8_STAGE(PG8_SB(0, 0), b2, voffB); PG8_STAGE(PG8_SB(0, 1), b2 + hstepB, voffB); PG8_STAGE(PG8_SA(0, 0), a2, voffA);
            PG8_WAIT_V(8); PG8_WAIT_L(0); PG8_BAR; PG8_MMA(1, 0, At, B0); PG8_MMA(1, 1, At, B1); PG8_BAR; PG8_SCHED;
            PG8_LDB(B0, 1, 0); PG8_LDB(B1, 1, 1); PG8_SCHED; PG8_LDA(At, 1, 0); PG8_STAGE(PG8_SA(0, 1), a2 + hstepA, voffA);
            PG8_WAIT_V(8); PG8_WAIT_L(0); PG8_BAR; PG8_MMA(0, 0, At, B0); PG8_MMA(0, 1, At, B1); PG8_BAR; PG8_SCHED;
            PG8_LDA(At, 1, 1); PG8_STAGE(PG8_SB(1, 0), b3, voffB); PG8_STAGE(PG8_SB(1, 1), b3 + hstepB, voffB); PG8_STAGE(PG8_SA(1, 0), a3, voffA);
            PG8_WAIT_V(8); PG8_WAIT_L(0); PG8_BAR; PG8_MMA(1, 0, At, B0); PG8_MMA(1, 1, At, B1); PG8_BAR; PG8_SCHED;
        }
        if (wr == 0) PG8_BAR;
        { int frl = fr, fql = fq, wrl = wr, wcl = wc; asm volatile("" : "+v"(frl), "+v"(fql), "+s"(wrl), "+s"(wcl));
          if constexpr (!job_drain<Job>::v) J.epi(acc, cur, wrl, wcl, frl, fql); }
        if (!has_next) break;
#pragma unroll
        for (int a = 0; a < 2; ++a)
#pragma unroll
            for (int b = 0; b < 2; ++b)
#pragma unroll
                for (int m = 0; m < 4; ++m)
#pragma unroll
                    for (int n = 0; n < 2; ++n) acc[a][b][m][n] = (f32x4){0.f, 0.f, 0.f, 0.f};
        cur = nxt; cA = nA; cB = nB; ks = ksN; ++ui;
        if (wr == 1) PG8_BAR;
    }
    PG8_WAIT_V(0);
    PG8_BAR;
    if constexpr (job_drain<Job>::v) J.epi_drain(acc, cur, lds, wr, wc, fr, fq);
#undef PG8_SA
#undef PG8_SB
#undef PG8_STAGE
#undef PG8_LDA
#undef PG8_LDB
#undef PG8_MMA
#undef PG8_WAIT_V
#undef PG8_WAIT_L
#undef PG8_BAR
#undef PG8_SCHED
}

__device__ __forceinline__ void store_tile_bf16(const Acc& acc, bf16_t* base, size_t ld, int wr, int wc, int fr, int fq, float sc) {
#pragma unroll
    for (int ai = 0; ai < 2; ++ai)
#pragma unroll
        for (int m = 0; m < 4; ++m) { bf16_t* rowp = base + (size_t)(128 * ai + 64 * wr + 16 * m + fr) * ld + 32 * wc + 8 * fq;
#pragma unroll
            for (int bj = 0; bj < 2; ++bj) *(u32x4*)(rowp + 128 * bj) = pk8(acc[ai][bj][m][0] * sc, acc[ai][bj][m][1] * sc); }
}

struct JobFfnUp {
    int nt, lda, ldb, nunits;
    const bf16_t* A; const bf16_t* W13; const float* rstd; bf16_t* act;
    const bf16_t* memn; const bf16_t* Wk; const bf16_t* Wv; bf16_t* KM; bf16_t* VT;
    __device__ __forceinline__ void get(int L, Unit& u, const char*& uA, const char*& uB) const {
        if (L < 2816) { int pm, pn; tile_map(L, 64, 44, pm, pn); uA = (const char*)(A + (size_t)pm * 256 * 2048); uB = (const char*)(W13 + (size_t)pn * 256 * 2048); u.x = pm; u.y = pn; u.z = 0; }
        else { const int i = L - 2816;
            if (i < 32) { const int pm = i >> 3, pn = i & 7; uA = (const char*)(memn + (size_t)pm * 256 * 2048); uB = (const char*)(Wk + (size_t)pn * 256 * 2048); u.x = pm; u.y = pn; u.z = 1; }
            else { const int k = i - 32, pm = k >> 2, pn = k & 3; uA = (const char*)(Wv + (size_t)pm * 256 * 2048); uB = (const char*)(memn + (size_t)pn * 256 * 2048); u.x = pm; u.y = pn; u.z = 2; } }
    }
    __device__ __forceinline__ void epi(Acc& acc, const Unit& u, int wr, int wc, int fr, int fq) const {
        if (u.z == 0) {
#pragma unroll
            for (int ai = 0; ai < 2; ++ai)
#pragma unroll
                for (int m = 0; m < 4; ++m) { const int r = u.x * 256 + 128 * ai + 64 * wr + 16 * m + fr; const float rs = rstd[r];
                    f32x4 o[2];
#pragma unroll
                    for (int n = 0; n < 2; ++n)
#pragma unroll
                        for (int j = 0; j < 4; ++j) { const float z1 = acc[ai][0][m][n][j] * rs, z3 = acc[ai][1][m][n][j] * rs; o[n][j] = z1 * sigm(z1) * z3; }
                    *(u32x4*)(act + (size_t)r * FF + u.y * 128 + 32 * wc + 8 * fq) = pk8(o[0], o[1]); }
        } else if (u.z == 1) { store_tile_bf16(acc, KM + (size_t)u.x * 256 * 2048 + u.y * 256, 2048, wr, wc, fr, fq, 1.0f); }
        else { store_tile_bf16(acc, VT + ((size_t)u.y * 2048 + u.x * 256) * 256, 256, wr, wc, fr, fq, 1.0f); }
    }
};

struct JobRes {
    int nt, lda, ldb, nunits;
    const bf16_t* A; const bf16_t* W; bf16_t* hb; float* pss; float scale;
    __device__ __forceinline__ void get(int L, Unit& u, const char*& uA, const char*& uB) const { int pm, pn; tile_map(L, 64, 8, pm, pn); uA = (const char*)(A + (size_t)pm * 256 * lda); uB = (const char*)(W + (size_t)pn * 256 * ldb); u.x = pm; u.y = pn; u.z = 0; }
    __device__ __forceinline__ void epi(Acc& acc, const Unit& u, int wr, int wc, int fr, int fq) const {
#pragma unroll
        for (int ai = 0; ai < 2; ++ai) {
            u32x4 rr[4][2];
#pragma unroll
            for (int m = 0; m < 4; ++m) { const size_t off = (size_t)(u.x * 256 + 128 * ai + 64 * wr + 16 * m + fr) * DM + u.y * 256 + 32 * wc + 8 * fq;
#pragma unroll
                for (int bj = 0; bj < 2; ++bj) rr[m][bj] = *(const u32x4*)(hb + off + 128 * bj); }
            asm volatile("" ::: "memory");
#pragma unroll
            for (int m = 0; m < 4; ++m) { const int r = u.x * 256 + 128 * ai + 64 * wr + 16 * m + fr; const size_t off = (size_t)r * DM + u.y * 256 + 32 * wc + 8 * fq; float ss = 0.f;
#pragma unroll
                for (int bj = 0; bj < 2; ++bj) { f32x4 r0, r1; unpk8(rr[m][bj], r0, r1); const f32x4 h0 = r0 + acc[ai][bj][m][0] * scale, h1 = r1 + acc[ai][bj][m][1] * scale;
                    *(u32x4*)(hb + off + 128 * bj) = pk8(h0, h1);
                    ss += (h0[0] * h0[0] + h0[1] * h0[1]) + (h0[2] * h0[2] + h0[3] * h0[3]) + (h1[0] * h1[0] + h1[1] * h1[1]) + (h1[2] * h1[2] + h1[3] * h1[3]); }
                if (pss) { ss += __shfl_xor(ss, 16); ss += __shfl_xor(ss, 32); if (fq == 0) pss[(size_t)r * 32 + u.y * 4 + wc] = ss; } }
            asm volatile("" ::: "memory");
        }
    }
};
struct JobWin1 {
    int nt, lda, ldb, nunits;
    const bf16_t* HB; const bf16_t* Win; const float* rstd; const float* RC; const float* RS; const float* RCt; const float* RSt;
    bf16_t* U2; bf16_t* Acat; bf16_t* Kb; bf16_t* KzT; bf16_t* Bcat;
    __device__ __forceinline__ void get(int L, Unit& u, const char*& uA, const char*& uB) const {
        if (L < 768) { int pm, pn; tile_map(L, 64, 12, pm, pn); uA = (const char*)(HB + (size_t)pm * 256 * 2048); uB = (const char*)(Win + (size_t)pn * 256 * 2048); u.x = pm; u.y = pn; u.z = 0; }
        else { int pm, pn; tile_map(L - 768, 8, 64, pm, pn); uA = (const char*)(Win + (size_t)(3072 + pm * 256) * 2048); uB = (const char*)(HB + (size_t)pn * 256 * 2048); u.x = pm; u.y = pn; u.z = 1; }
    }
    __device__ __forceinline__ void epi(Acc& acc, const Unit& u, int wr, int wc, int fr, int fq) const {
        if (u.z == 0) {
            const int b = u.x >> 4;
            if (u.y < 4) {
#pragma unroll
                for (int ai = 0; ai < 2; ++ai)
#pragma unroll
                    for (int m = 0; m < 4; ++m) { const int r = u.x * 256 + 128 * ai + 64 * wr + 16 * m + fr; const float rs = rstd[r]; const int l = r & 4095, c = l >> 4, jj = l & 15;
#pragma unroll
                        for (int bj = 0; bj < 2; ++bj) { const int col = u.y * 256 + 128 * bj + 32 * wc + 8 * fq, g = col >> 4, ci0 = col & 15;
                            *(u32x4*)(U2 + ((size_t)g * 1024 + b * 256 + c) * 384 + jj * 16 + ci0) = pk8(acc[ai][bj][m][0] * rs, acc[ai][bj][m][1] * rs); } }
            } else {
                const bool isq = u.y < 8; const int h = (u.y - 4) & 3; const float lg = lgam(h);
                float rsv[2][4];
#pragma unroll
                for (int ai = 0; ai < 2; ++ai)
#pragma unroll
                    for (int m = 0; m < 4; ++m) rsv[ai][m] = rstd[u.x * 256 + 128 * ai + 64 * wr + 16 * m + fr];
#pragma unroll
                for (int ai = 0; ai < 2; ++ai)
#pragma unroll
                    for (int m = 0; m < 4; ++m) { const int r = u.x * 256 + 128 * ai + 64 * wr + 16 * m + fr; const int l = r & 4095; const int i0 = 32 * wc + 8 * fq;
                        float rs = rsv[ai][m];
                        if (isq) rs *= exp2f((float)((l & 255) + 1) * lg); else rs = rs * rs * 0.0625f;
                        f32x4 o1[2], o2[2];
#pragma unroll
                        for (int n = 0; n < 2; ++n) { const f32x4 cs = *(const f32x4*)(RC + (size_t)l * 128 + i0 + 4 * n), sn = *(const f32x4*)(RS + (size_t)l * 128 + i0 + 4 * n);
                            const f32x4 t1 = acc[ai][0][m][n] * rs, t2 = acc[ai][1][m][n] * rs; o1[n] = t1 * cs - t2 * sn; o2[n] = t1 * sn + t2 * cs; }
                        if (isq) { bf16_t* dst = Acat + ((size_t)((b * 4 + h) * 16 + (l >> 8)) * 256 + (l & 255)) * 512 + 256 + i0;
                            *(u32x4*)dst = pk8(o1[0], o1[1]); *(u32x4*)(dst + 128) = pk8(o2[0], o2[1]); }
                        else { bf16_t* dst = Kb + (size_t)r * 1024 + h * 256 + i0; *(u32x4*)dst = pk8(o1[0], o1[1]); *(u32x4*)(dst + 128) = pk8(o2[0], o2[1]);
                            const float zt = exp2f((float)(255 - (l & 255)) * lg);
                            bf16_t* kz = KzT + ((size_t)(b * 4 + h) * 256 + i0) * 4096 + l;
#pragma unroll
                            for (int n = 0; n < 2; ++n)
#pragma unroll
                                for (int j = 0; j < 4; ++j) { kz[(size_t)(4 * n + j) * 4096] = (bf16_t)(pk2(o1[n][j] * zt, 0.f) & 0xffffu); kz[(size_t)(128 + 4 * n + j) * 4096] = (bf16_t)(pk2(o2[n][j] * zt, 0.f) & 0xffffu); } }
                        asm volatile("" ::: "memory"); }
            }
        } else {
            const int b = u.y >> 4, lbase = (u.y & 15) * 256;
            {
                const int vt = u.x, h = vt >> 1, e0 = (vt & 1) * 256, c = u.y & 15;
                bf16_t* base = Bcat + ((size_t)((b * 4 + h) * 16 + c) * 512 + e0) * 512;
#pragma unroll
                for (int bj = 0; bj < 2; ++bj) { const int lc = 128 * bj + 32 * wc + 8 * fq;
#pragma unroll
                    for (int ai = 0; ai < 2; ++ai)
#pragma unroll
                        for (int m = 0; m < 4; ++m) *(u32x4*)(base + (size_t)(128 * ai + 64 * wr + 16 * m + fr) * 512 + lc) = pk8(acc[ai][bj][m][0], acc[ai][bj][m][1]); }
            }
        }
    }
};

struct JobScores {
    int nt, lda, ldb, nunits; bf16_t* Acat; const bf16_t* Kb;
    __device__ __forceinline__ void get(int L, Unit& u, const char*& uA, const char*& uB) const { const int bh = L >> 4, c = L & 15, b = bh >> 2, h = bh & 3;
        uA = (const char*)(Acat + (size_t)L * 256 * 512 + 256); uB = (const char*)(Kb + ((size_t)(b * 4096 + c * 256)) * 1024 + h * 256); u.x = L; u.y = h; u.z = 0; }
    __device__ __forceinline__ void epi(Acc& acc, const Unit& u, int wr, int wc, int fr, int fq) const {
        const float lg = lgam(u.y); bf16_t* base = Acat + (size_t)u.x * 256 * 512;
#pragma unroll
        for (int bj = 0; bj < 2; ++bj) { const int jc = 128 * bj + 32 * wc + 8 * fq; f32x4 w[2];
#pragma unroll
            for (int n = 0; n < 2; ++n)
#pragma unroll
                for (int j = 0; j < 4; ++j) w[n][j] = exp2f(-(float)(jc + 4 * n + j + 1) * lg);
#pragma unroll
            for (int ai = 0; ai < 2; ++ai)
#pragma unroll
                for (int m = 0; m < 4; ++m) { const int i = 128 * ai + 64 * wr + 16 * m + fr; f32x4 o[2];
#pragma unroll
                    for (int n = 0; n < 2; ++n)
#pragma unroll
                        for (int j = 0; j < 4; ++j) { const unsigned msk = (unsigned)((jc + 4 * n + j - i - 1) >> 31);
                            o[n][j] = __uint_as_float(__float_as_uint(acc[ai][bj][m][n][j] * w[n][j]) & msk); }
                    *(u32x4*)(base + (size_t)i * 512 + jc) = pk8(o[0], o[1]); asm volatile("" ::: "memory"); } }
    }
};
struct JobKV {
    int nt, lda, ldb, nunits; bf16_t* Bcat; const bf16_t* KzT;
    __device__ __forceinline__ void get(int L, Unit& u, const char*& uA, const char*& uB) const { const int bhc = L >> 1, et = L & 1, bh = bhc >> 4, c = bhc & 15;
        uA = (const char*)(Bcat + ((size_t)bhc * 512 + et * 256) * 512); uB = (const char*)(KzT + (size_t)bh * 256 * 4096 + c * 256); u.x = bhc; u.y = et; u.z = 0; }
    __device__ __forceinline__ void epi(Acc& acc, const Unit& u, int wr, int wc, int fr, int fq) const {
        store_tile_bf16(acc, Bcat + ((size_t)u.x * 512 + u.y * 256) * 512 + 256, 512, wr, wc, fr, fq, 1.0f); }
};
struct JobS5P1 {
    int nt, lda, ldb, nunits; const bf16_t* U2; const bf16_t* MB; float* XL;
    __device__ __forceinline__ void get(int L, Unit& u, const char*& uA, const char*& uB) const { const int g = L >> 2, b = L & 3;
        uA = (const char*)(U2 + ((size_t)g * 1024 + b * 256) * 384); uB = (const char*)(MB + (size_t)g * 128 * 256); u.x = g; u.y = b; u.z = 0; }
    __device__ __forceinline__ void epi(Acc& acc, const Unit& u, int wr, int wc, int fr, int fq) const {
#pragma unroll
        for (int ai = 0; ai < 2; ++ai)
#pragma unroll
            for (int m = 0; m < 4; ++m) { float* p = XL + ((size_t)u.x * 1024 + u.y * 256 + 128 * ai + 64 * wr + 16 * m + fr) * 128 + 32 * wc + 8 * fq;
                *(f32x4*)p = acc[ai][0][m][0]; *(f32x4*)(p + 4) = acc[ai][0][m][1]; }
    }
};
struct JobRetOut {
    int nt, lda, ldb, nunits; const bf16_t* Acat; const bf16_t* Bcat; bf16_t* O; float* GNP;
    __device__ __forceinline__ void get(int L, Unit& u, const char*& uA, const char*& uB) const { const int bhc = L >> 1, et = L & 1;
        uA = (const char*)(Acat + (size_t)bhc * 256 * 512); uB = (const char*)(Bcat + ((size_t)bhc * 512 + et * 256) * 512); u.x = bhc; u.y = et; u.z = 0; }
    __device__ __forceinline__ void epi(Acc& acc, const Unit& u, int wr, int wc, int fr, int fq) const { const int bh = u.x >> 4, c = u.x & 15, b = bh >> 2, h = bh & 3;
        store_tile_bf16(acc, O + (size_t)(b * 4096 + c * 256) * 2048 + h * 512 + u.y * 256, 2048, wr, wc, fr, fq, 1.0f);
#pragma unroll
        for (int ai = 0; ai < 2; ++ai)
#pragma unroll
            for (int m = 0; m < 4; ++m) { float s1 = 0.f, s2 = 0.f;
#pragma unroll
                for (int bj = 0; bj < 2; ++bj)
#pragma unroll
                    for (int n = 0; n < 2; ++n) { const f32x4 v = acc[ai][bj][m][n]; s1 += (v[0] + v[1]) + (v[2] + v[3]); s2 += (v[0] * v[0] + v[1] * v[1]) + (v[2] * v[2] + v[3] * v[3]); }
                s1 += __shfl_xor(s1, 16); s1 += __shfl_xor(s1, 32); s2 += __shfl_xor(s2, 16); s2 += __shfl_xor(s2, 32);
                if (fq == 0) { const int tok = b * 4096 + c * 256 + 128 * ai + 64 * wr + 16 * m + fr; float* g = GNP + (((size_t)tok * 4 + h) * 8 + u.y * 4 + wc) * 2; g[0] = s1; g[1] = s2; } }
    }
};
struct JobS5P2 {
    int nt, lda, ldb, nunits; const bf16_t* U2; const bf16_t* BT2; bf16_t* Yact;
    __device__ __forceinline__ void get(int L, Unit& u, const char*& uA, const char*& uB) const { const int g = L >> 2, b = L & 3;
        uA = (const char*)(U2 + ((size_t)g * 1024 + b * 256) * 384); uB = (const char*)(BT2 + (size_t)g * 256 * 384); u.x = g; u.y = b; u.z = 0; }
    __device__ __forceinline__ void epi(Acc& acc, const Unit& u, int wr, int wc, int fr, int fq) const {
#pragma unroll
        for (int ai = 0; ai < 2; ++ai)
#pragma unroll
            for (int m = 0; m < 4; ++m) { const int c = 128 * ai + 64 * wr + 16 * m + fr;
#pragma unroll
                for (int bj = 0; bj < 2; ++bj) { const int col = 128 * bj + 32 * wc + 8 * fq, t = col >> 4, ch0 = col & 15; f32x4 o[2];
#pragma unroll
                    for (int n = 0; n < 2; ++n)
#pragma unroll
                        for (int j = 0; j < 4; ++j) { const float y = acc[ai][bj][m][n][j]; o[n][j] = y * sigm(1.5957691216f * (y + 0.044715f * y * y * y)); }
                    *(u32x4*)(Yact + (size_t)(u.y * 4096 + c * 16 + t) * 1024 + u.x * 16 + ch0) = pk8(o[0], o[1]); } }
    }
};
struct JobGret {
    int nt, lda, ldb, nunits; const bf16_t* HB; const bf16_t* W; const float* rstd; const float* GNS; bf16_t* O;
    __device__ __forceinline__ void get(int L, Unit& u, const char*& uA, const char*& uB) const { int pm, pn; tile_map(L, 64, 8, pm, pn); uA = (const char*)(HB + (size_t)pm * 256 * 2048); uB = (const char*)(W + (size_t)pn * 256 * 2048); u.x = pm; u.y = pn; u.z = 0; }
    __device__ __forceinline__ void epi(Acc& acc, const Unit& u, int wr, int wc, int fr, int fq) const {
#pragma unroll
        for (int aq = 0; aq < 4; ++aq) { const int ai = aq >> 1, m0 = (aq & 1) * 2;
            f32x4 gs[4][4]; u32x4 ov[4][2]; float rsv[4];
#pragma unroll
            for (int m = m0; m < m0 + 2; ++m) { const int r = u.x * 256 + 128 * ai + 64 * wr + 16 * m + fr; rsv[m] = rstd[r];
                const f32x4* g = (const f32x4*)(GNS + ((size_t)r * 4 + (u.y >> 1)) * 16); gs[m][0] = g[0]; gs[m][1] = g[1]; gs[m][2] = g[2]; gs[m][3] = g[3];
#pragma unroll
                for (int bj = 0; bj < 2; ++bj) ov[m][bj] = *(const u32x4*)(O + (size_t)r * 2048 + u.y * 256 + 128 * bj + 32 * wc + 8 * fq); }
            asm volatile("" ::: "memory");
#pragma unroll
            for (int m = m0; m < m0 + 2; ++m) { const int r = u.x * 256 + 128 * ai + 64 * wr + 16 * m + fr; const float rs = rsv[m];
                const f32x4 a = gs[m][0], bq = gs[m][1], cq = gs[m][2], d = gs[m][3];
                const float s1 = (a[0] + a[2]) + (bq[0] + bq[2]) + (cq[0] + cq[2]) + (d[0] + d[2]), s2 = (a[1] + a[3]) + (bq[1] + bq[3]) + (cq[1] + cq[3]) + (d[1] + d[3]);
                const float mean = s1 * (1.0f / 512.0f), grs = rsqrtf(fmaxf(s2 * (1.0f / 512.0f) - mean * mean, 0.f) + 1e-5f);
#pragma unroll
                for (int bj = 0; bj < 2; ++bj) { bf16_t* p = O + (size_t)r * 2048 + u.y * 256 + 128 * bj + 32 * wc + 8 * fq; f32x4 o0, o1; unpk8(ov[m][bj], o0, o1);
#pragma unroll
                    for (int j = 0; j < 4; ++j) { const float g0 = acc[ai][bj][m][0][j] * rs, g1 = acc[ai][bj][m][1][j] * rs; o0[j] = g0 * sigm(g0) * (o0[j] - mean) * grs; o1[j] = g1 * sigm(g1) * (o1[j] - mean) * grs; }
                    *(u32x4*)p = pk8(o0, o1); } }
            asm volatile("" ::: "memory");
        }
    }
};
struct JobGlu {
    int nt, lda, ldb, nunits; const bf16_t* Yact; const bf16_t* W; bf16_t* YA;
    __device__ __forceinline__ void get(int L, Unit& u, const char*& uA, const char*& uB) const { int pm, pn; tile_map(L, 64, 16, pm, pn); uA = (const char*)(Yact + (size_t)pm * 256 * 1024); uB = (const char*)(W + (size_t)pn * 256 * 1024); u.x = pm; u.y = pn; u.z = 0; }
    __device__ __forceinline__ void epi(Acc& acc, const Unit& u, int wr, int wc, int fr, int fq) const {
#pragma unroll
        for (int ai = 0; ai < 2; ++ai)
#pragma unroll
            for (int m = 0; m < 4; ++m) { const int r = u.x * 256 + 128 * ai + 64 * wr + 16 * m + fr; f32x4 o[2];
#pragma unroll
                for (int n = 0; n < 2; ++n)
#pragma unroll
                    for (int j = 0; j < 4; ++j) o[n][j] = acc[ai][0][m][n][j] * sigm(acc[ai][1][m][n][j]);
                *(u32x4*)(YA + (size_t)r * 2048 + u.y * 128 + 32 * wc + 8 * fq) = pk8(o[0], o[1]); }
    }
};
struct JobPlain {
    int nt, lda, ldb, nunits; const bf16_t* A; const bf16_t* W; bf16_t* out; const float* rstd; float sc;
    __device__ __forceinline__ void get(int L, Unit& u, const char*& uA, const char*& uB) const { int pm, pn; tile_map(L, 64, 8, pm, pn); uA = (const char*)(A + (size_t)pm * 256 * 2048); uB = (const char*)(W + (size_t)pn * 256 * 2048); u.x = pm; u.y = pn; u.z = 0; }
    __device__ __forceinline__ void epi(Acc& acc, const Unit& u, int wr, int wc, int fr, int fq) const {
#pragma unroll
        for (int ai = 0; ai < 2; ++ai)
#pragma unroll
            for (int m = 0; m < 4; ++m) { const int r = u.x * 256 + 128 * ai + 64 * wr + 16 * m + fr; const float s = rstd ? rstd[r] * sc : sc;
#pragma unroll
                for (int bj = 0; bj < 2; ++bj) *(u32x4*)(out + (size_t)r * 2048 + u.y * 256 + 128 * bj + 32 * wc + 8 * fq) = pk8(acc[ai][bj][m][0] * s, acc[ai][bj][m][1] * s); }
    }
};
struct JobGate {
    int nt, lda, ldb, nunits; const bf16_t* HB; const bf16_t* W; const float* rstd; bf16_t* YA; const bf16_t* YB; int mode;
    __device__ __forceinline__ void get(int L, Unit& u, const char*& uA, const char*& uB) const { int pm, pn; tile_map(L, 64, 8, pm, pn); uA = (const char*)(HB + (size_t)pm * 256 * 2048); uB = (const char*)(W + (size_t)pn * 256 * 2048); u.x = pm; u.y = pn; u.z = 0; }
    __device__ __forceinline__ void epi(Acc& acc, const Unit& u, int wr, int wc, int fr, int fq) const {
#pragma unroll
        for (int aq = 0; aq < 4; ++aq) { const int ai = aq >> 1, m0 = (aq & 1) * 2;
            u32x4 av[4][2], bv[4][2]; float rsv[4];
#pragma unroll
            for (int m = m0; m < m0 + 2; ++m) { const int r = u.x * 256 + 128 * ai + 64 * wr + 16 * m + fr; rsv[m] = rstd[r];
#pragma unroll
                for (int bj = 0; bj < 2; ++bj) { const size_t off = (size_t)r * 2048 + u.y * 256 + 128 * bj + 32 * wc + 8 * fq; av[m][bj] = *(const u32x4*)(YA + off); bv[m][bj] = mode ? *(const u32x4*)(YB + off) : (u32x4){0u, 0u, 0u, 0u}; } }
            asm volatile("" ::: "memory");
#pragma unroll
            for (int m = m0; m < m0 + 2; ++m) { const int r = u.x * 256 + 128 * ai + 64 * wr + 16 * m + fr; const float rs = rsv[m];
#pragma unroll
                for (int bj = 0; bj < 2; ++bj) { const size_t off = (size_t)r * 2048 + u.y * 256 + 128 * bj + 32 * wc + 8 * fq; f32x4 a0, a1; unpk8(av[m][bj], a0, a1);
                    if (mode == 0) {
#pragma unroll
                        for (int j = 0; j < 4; ++j) { a0[j] *= sigm(acc[ai][bj][m][0][j] * rs); a1[j] *= sigm(acc[ai][bj][m][1][j] * rs); }
                    } else { f32x4 b0, b1; unpk8(bv[m][bj], b0, b1);
#pragma unroll
                        for (int j = 0; j < 4; ++j) { a0[j] += sigm(acc[ai][bj][m][0][j] * rs) * b0[j]; a1[j] += sigm(acc[ai][bj][m][1][j] * rs) * b1[j]; } }
                    *(u32x4*)(YA + off) = pk8(a0, a1); } }
            asm volatile("" ::: "memory");
        }
    }
};
struct JobGate2 {
    int nt, lda, ldb, nunits; const bf16_t* HB; const bf16_t* W; const float* rstd; bf16_t* YA; const bf16_t* YB; int own;
    __device__ __forceinline__ void get(int L, Unit& u, const char*& uA, const char*& uB) const { int pm, pn;
        if (own) { const int c = L & 255, i = L >> 8; pm = 8 * (c & 7) + ((c >> 3) & 7); pn = 2 * ((c >> 6) + 4 * (i >> 1)) + (i & 1); } else tile_map(L, 64, 16, pm, pn);
        uA = (const char*)(HB + (size_t)pm * 256 * 2048); uB = (const char*)(W + (size_t)pn * 256 * 2048); u.x = pm; u.y = pn; u.z = 0; }
    __device__ __forceinline__ void epi(Acc& acc, const Unit& u, int wr, int wc, int fr, int fq) const {
#pragma unroll
        for (int ai = 0; ai < 2; ++ai) {
            u32x4 av[4], bv[4]; float rsv[4];
#pragma unroll
            for (int m = 0; m < 4; ++m) { const int r = u.x * 256 + 128 * ai + 64 * wr + 16 * m + fr; rsv[m] = rstd[r];
                const size_t off = (size_t)r * 2048 + u.y * 128 + 32 * wc + 8 * fq; av[m] = *(const u32x4*)(YA + off); bv[m] = *(const u32x4*)(YB + off); }
            asm volatile("" ::: "memory");
#pragma unroll
            for (int m = 0; m < 4; ++m) { const int r = u.x * 256 + 128 * ai + 64 * wr + 16 * m + fr; const float rs = rsv[m];
                const size_t off = (size_t)r * 2048 + u.y * 128 + 32 * wc + 8 * fq; f32x4 a0, a1, b0, b1; unpk8(av[m], a0, a1); unpk8(bv[m], b0, b1);
#pragma unroll
                for (int j = 0; j < 4; ++j) { a0[j] = sigm(acc[ai][0][m][0][j] * rs) * a0[j] + sigm(acc[ai][1][m][0][j] * rs) * b0[j]; a1[j] = sigm(acc[ai][0][m][1][j] * rs) * a1[j] + sigm(acc[ai][1][m][1][j] * rs) * b1[j]; }
                *(u32x4*)(YA + off) = pk8(a0, a1); }
            asm volatile("" ::: "memory");
        }
    }
};
struct JobXs {
    int nt, lda, ldb, nunits; const bf16_t* XQ; const bf16_t* KM; bf16_t* P; int base;
    __device__ __forceinline__ void get(int L0, Unit& u, const char*& uA, const char*& uB) const { const int L = L0 + base, bh = L >> 4, qt = L & 15, b = bh >> 2, h = bh & 3;
        uA = (const char*)(XQ + (size_t)(b * 4096 + qt * 256) * 2048 + h * 512); uB = (const char*)(KM + (size_t)(b * 256) * 2048 + h * 512); u.x = L; u.y = 0; u.z = 0; }
    __device__ __forceinline__ void epi_drain(Acc& acc, const Unit& u, LAS unsigned char* lds, int wr, int wc, int fr, int fq) const {
        LAS float* MX = (LAS float*)lds; LAS float* SM = MX + 1024;
#pragma unroll
        for (int ai = 0; ai < 2; ++ai)
#pragma unroll
            for (int m = 0; m < 4; ++m) { float mx = -3.0e38f;
#pragma unroll
                for (int bj = 0; bj < 2; ++bj)
#pragma unroll
                    for (int n = 0; n < 2; ++n) { const f32x4 v = acc[ai][bj][m][n]; mx = fmaxf(mx, fmaxf(fmaxf(v[0], v[1]), fmaxf(v[2], v[3]))); }
                mx = fmaxf(mx, __shfl_xor(mx, 16)); mx = fmaxf(mx, __shfl_xor(mx, 32));
                if (fq == 0) MX[(128 * ai + 64 * wr + 16 * m + fr) * 4 + wc] = mx; }
        asm volatile("s_waitcnt lgkmcnt(0)" ::: "memory"); __syncthreads();
#pragma unroll
        for (int ai = 0; ai < 2; ++ai)
#pragma unroll
            for (int m = 0; m < 4; ++m) { const int row = 128 * ai + 64 * wr + 16 * m + fr; const f32x4 q = *(const LAS f32x4*)(MX + row * 4);
                const float mx = fmaxf(fmaxf(q[0], q[1]), fmaxf(q[2], q[3])); float s = 0.f;
#pragma unroll
                for (int bj = 0; bj < 2; ++bj)
#pragma unroll
                    for (int n = 0; n < 2; ++n) { f32x4 v = acc[ai][bj][m][n];
#pragma unroll
                        for (int j = 0; j < 4; ++j) v[j] = __expf(v[j] - mx);
                        acc[ai][bj][m][n] = v; s += (v[0] + v[1]) + (v[2] + v[3]); }
                s += __shfl_xor(s, 16); s += __shfl_xor(s, 32);
                if (fq == 0) SM[row * 4 + wc] = s; }
        asm volatile("s_waitcnt lgkmcnt(0)" ::: "memory"); __syncthreads();
#pragma unroll
        for (int ai = 0; ai < 2; ++ai)
#pragma unroll
            for (int m = 0; m < 4; ++m) { const int row = 128 * ai + 64 * wr + 16 * m + fr; const f32x4 q = *(const LAS f32x4*)(SM + row * 4);
                const float inv = 1.0f / ((q[0] + q[1]) + (q[2] + q[3])); bf16_t* rowp = P + ((size_t)u.x * 256 + row) * 256 + 32 * wc + 8 * fq;
#pragma unroll
                for (int bj = 0; bj < 2; ++bj) *(u32x4*)(rowp + 128 * bj) = pk8(acc[ai][bj][m][0] * inv, acc[ai][bj][m][1] * inv); }
        __syncthreads();
    }
};
template <> struct job_drain<JobXs> { static constexpr bool v = true; };
struct JobPv {
    int nt, lda, ldb, nunits; const bf16_t* P; const bf16_t* VT; bf16_t* XO;
    __device__ __forceinline__ void get(int L, Unit& u, const char*& uA, const char*& uB) const { const int bhq = L >> 1, et = L & 1, bh = bhq >> 4, b = bh >> 2, h = bh & 3;
        uA = (const char*)(P + (size_t)bhq * 256 * 256); uB = (const char*)(VT + ((size_t)b * 2048 + h * 512 + et * 256) * 256); u.x = bhq; u.y = et; u.z = 0; }
    __device__ __forceinline__ void epi(Acc& acc, const Unit& u, int wr, int wc, int fr, int fq) const { const int bh = u.x >> 4, qt = u.x & 15, b = bh >> 2, h = bh & 3;
        store_tile_bf16(acc, XO + (size_t)(b * 4096 + qt * 256) * 2048 + h * 512 + u.y * 256, 2048, wr, wc, fr, fq, 1.0f); }
};

__device__ __forceinline__ void transpose_item(const float* W, int K, int N, bf16_t* WT, int mode, const float* gain, LAS float* scr, int item, int lane) {
    const int nblk = N / 64, kb = item / nblk, nb = item % nblk, k0 = 64 * kb, n0 = 64 * nb;
    const int ro = lane >> 4, c4 = (lane & 15) * 4;
    f32x4 v[16];
#pragma unroll
    for (int i = 0; i < 16; ++i) v[i] = *(const f32x4*)(W + (size_t)(k0 + 4 * i + ro) * N + n0 + c4);
#pragma unroll
    for (int i = 0; i < 16; ++i) { const float g = gain ? gain[k0 + 4 * i + ro] : 1.0f; LAS float* s = scr + (4 * i + ro) * 65 + c4; s[0] = v[i][0] * g; s[1] = v[i][1] * g; s[2] = v[i][2] * g; s[3] = v[i][3] * g; }
    asm volatile("s_waitcnt lgkmcnt(0)" ::: "memory");
    const int c = lane & 7; int d0 = mode == 0 ? n0 : ((n0 >> 7) * 256 + (mode == 2 ? 128 : 0) + (n0 & 127));
    if (mode == 4) { if (n0 < 7168) d0 = n0; else { const int jg = (n0 - 7168) & 2047, sel = (n0 - 7168) >> 11; d0 = 7168 + (jg >> 7) * 256 + sel * 128 + (jg & 127); } }
#pragma unroll
    for (int j = 0; j < 8; ++j) { const int n = (lane >> 3) + 8 * j; const LAS float* s = scr + (8 * c) * 65 + n;
        u32x4 o; o.x = pk2(s[0 * 65], s[1 * 65]); o.y = pk2(s[2 * 65], s[3 * 65]); o.z = pk2(s[4 * 65], s[5 * 65]); o.w = pk2(s[6 * 65], s[7 * 65]);
        *(u32x4*)(WT + (size_t)(d0 + n) * K + k0 + 8 * c) = o; }
    asm volatile("s_waitcnt lgkmcnt(0)" ::: "memory");
}
#define TMAT(Wp, Kd, Nd, WTp, mode, gainp) { const int ni_ = ((Kd) / 64) * ((Nd) / 64); if (r < ni_) { transpose_item(Wp, Kd, Nd, WTp, mode, gainp, scr, r, lane); continue; } r -= ni_; }

__device__ __forceinline__ float row_sumsq_load(const float* xrow, int lane, f32x4 (&v)[8]) {
    float s = 0.f;
#pragma unroll
    for (int j = 0; j < 8; ++j) { v[j] = *(const f32x4*)(xrow + 4 * (lane + 64 * j)); s += (v[j][0] * v[j][0] + v[j][1] * v[j][1]) + (v[j][2] * v[j][2] + v[j][3] * v[j][3]); }
    return wave_sum(s);
}

__device__ __forceinline__ void s5_prep_item(const Params& p, LAS float* L, int g, int part, int tid) {
    LAS float* POWr = L; LAS float* POWi = L + 1088; LAS float* BBr = L + 2176; LAS float* BBi = L + 3200; LAS float* CCr = L + 4224; LAS float* CCi = L + 5248; LAS float* KL = L + 6272;
    const double dt = exp((double)p.in[I_LDT][g]);
    for (int idx = tid; idx < 64 * 17; idx += NTHR) { const int pp = idx / 17, tau = idx % 17; const double ar = p.in[I_ARE][g * 64 + pp], ai = p.in[I_AIM][g * 64 + pp];
        const double mag = exp(ar * dt * tau), ang = ai * dt * tau; POWr[idx] = (float)(mag * cos(ang)); POWi[idx] = (float)(mag * sin(ang)); }
    for (int idx = tid; idx < 64 * 16; idx += NTHR) { const int pp = idx >> 4; const double ar = p.in[I_ARE][g * 64 + pp], ai = p.in[I_AIM][g * 64 + pp];
        const double mag = exp(ar * dt), lre = mag * cos(ai * dt), lim = mag * sin(ai * dt), den = ar * ar + ai * ai, nr = lre - 1.0, ni = lim;
        const double fre = (nr * ar + ni * ai) / den, fim = (ni * ar - nr * ai) / den; const double br = p.in[I_BRE][(size_t)g * 1024 + idx], bi = p.in[I_BIM][(size_t)g * 1024 + idx];
        BBr[idx] = (float)(fre * br - fim * bi); BBi[idx] = (float)(fre * bi + fim * br); }
    for (int idx = tid; idx < 1024; idx += NTHR) { CCr[idx] = p.in[I_CRE][(size_t)g * 1024 + idx]; CCi[idx] = p.in[I_CIM][(size_t)g * 1024 + idx]; }
    __syncthreads();
    { const int ci = tid & 15, ch = (tid >> 4) & 15, half = tid >> 8; float s[8];
#pragma unroll
      for (int k = 0; k < 8; ++k) s[k] = 0.f;
      for (int pp = 0; pp < 64; ++pp) { const float cr = CCr[ch * 64 + pp], cim = CCi[ch * 64 + pp], br = BBr[pp * 16 + ci], bi = BBi[pp * 16 + ci];
          const float er = cr * br - cim * bi, ei = cr * bi + cim * br;
#pragma unroll
          for (int k = 0; k < 8; ++k) s[k] += er * POWr[pp * 17 + 8 * half + k] - ei * POWi[pp * 17 + 8 * half + k]; }
#pragma unroll
      for (int k = 0; k < 8; ++k) KL[(8 * half + k) * 256 + ch * 16 + ci] = s[k]; }
    __syncthreads();
    bf16_t* BT2 = (bf16_t*)(p.ws + WS_BT2); bf16_t* MB = (bf16_t*)(p.ws + WS_MB);
    for (int idx = tid; idx < 64 * 192; idx += NTHR) { const int rr = idx / 192, kp = idx % 192, n = part * 64 + rr, t = n >> 4, ch = n & 15; float v[2];
#pragma unroll
        for (int q = 0; q < 2; ++q) { const int k = 2 * kp + q;
            if (k < 256) { const int j = k >> 4, ci = k & 15; float x = (t >= j) ? KL[((t - j) * 16 + ch) * 16 + ci] : 0.f; if (t == j && ch == ci) x += p.in[I_S5D][g * 16 + ch]; v[q] = x; }
            else { const int kk = k - 256, pp = kk & 63; const float pr = POWr[pp * 17 + t + 1], pi = POWi[pp * 17 + t + 1], cr = CCr[ch * 64 + pp], ci_ = CCi[ch * 64 + pp];
                v[q] = kk < 64 ? (cr * pr - ci_ * pi) : -(cr * pi + ci_ * pr); } }
        *(unsigned*)(BT2 + ((size_t)g * 256 + n) * 384 + 2 * kp) = pk2(v[0], v[1]); }
    for (int idx = tid; idx < 32 * 128; idx += NTHR) { const int rr = idx >> 7, kp = idx & 127, s = part * 32 + rr, pp = s & 63, im = s >> 6; float v[2];
#pragma unroll
        for (int q = 0; q < 2; ++q) { const int k = 2 * kp + q, j = k >> 4, ci = k & 15; const float pr = POWr[pp * 17 + 15 - j], pi = POWi[pp * 17 + 15 - j], br = BBr[pp * 16 + ci], bi = BBi[pp * 16 + ci];
            v[q] = im ? (pr * bi + pi * br) : (pr * br - pi * bi); }
        *(unsigned*)(MB + ((size_t)g * 128 + s) * 256 + 2 * kp) = pk2(v[0], v[1]); }
    if (part == 0) { float* L16 = (float*)(p.ws + WS_L16); for (int idx = tid; idx < 64; idx += NTHR) { L16[(g * 64 + idx) * 2] = POWr[idx * 17 + 16]; L16[(g * 64 + idx) * 2 + 1] = POWi[idx * 17 + 16]; } }
    __syncthreads();
}

__device__ __forceinline__ void convert_ffn(const Params& p, LAS unsigned char* lds, int iw1, int iw3, int iw2, int ign, int gw, int NGW, int wave, int lane) {
    LAS float* scr = (LAS float*)(lds + wave * 16640);
    bf16_t* W13 = (bf16_t*)(p.ws + WS_W13); bf16_t* W2 = (bf16_t*)(p.ws + WS_W2);
    constexpr int NI = 3 * (2048 / 64) * (5632 / 64);
    for (int it = gw; it < NI; it += NGW) { int r = it;
        TMAT(p.in[iw1], 2048, 5632, W13, 1, p.in[ign])
        TMAT(p.in[iw3], 2048, 5632, W13, 2, p.in[ign])
        TMAT(p.in[iw2], 5632, 2048, W2, 0, (const float*)nullptr)
    }
}

#define XB_TMO      128
#define XB_XCNT(j)  (256  + 64 * (j))
#define XB_XSUB(j)  (1280 + 64 * (j))
#define XB_XGEN(j)  (2304 + 64 * (j))
#define XB_TOP      3328
#define XB_TOPGEN   3392
#define XCD_BAR_WORDS 3456
#define XB_SPIN_CAP (1u << 20)
__device__ __forceinline__ unsigned xb_ld(unsigned* p)              { return __hip_atomic_load(p, __ATOMIC_RELAXED, __HIP_MEMORY_SCOPE_AGENT); }
__device__ __forceinline__ unsigned xb_add(unsigned* p, unsigned v) { return __hip_atomic_fetch_add(p, v, __ATOMIC_RELAXED, __HIP_MEMORY_SCOPE_AGENT); }
__device__ __forceinline__ unsigned xb_xcc_id() { return (unsigned)__builtin_amdgcn_s_getreg((3 << 11) | 20) & 0xFu; }
#define XB_SPIN(cond, bar) do { unsigned _sp = 0; while (cond) { __builtin_amdgcn_s_sleep(1); \
    if ((++_sp & 255u) == 0u) { if (xb_ld(&(bar)[XB_TMO])) break; if (_sp > XB_SPIN_CAP) { atomicAdd(&(bar)[XB_TMO], 1u); break; } } } } while (0)
__device__ __forceinline__ void xcd_barrier_complete(unsigned* bar, unsigned x, unsigned& nloc, unsigned& nx) {
    const unsigned G = gridDim.x;
    unsigned sum, cnt, mine, sp = 0u;
    for (;;) {
        sum = 0u; cnt = 0u; mine = 0u;
#pragma unroll
        for (unsigned j = 0; j < 16; ++j) { const unsigned c = xb_ld(&bar[XB_XCNT(j)]); sum += c; cnt += (c > 0u) ? 1u : 0u; mine = (j == x) ? c : mine; }
        if (sum == G) break;
        __builtin_amdgcn_s_sleep(1);
        if ((++sp & 255u) == 0u) { if (xb_ld(&bar[XB_TMO])) break; if (sp > XB_SPIN_CAP) { atomicAdd(&bar[XB_TMO], 1u); break; } }
    }
    nloc = mine > 0u ? mine : 1u; nx = cnt > 0u ? cnt : 1u;
}
__device__ __forceinline__ void xcd_barrier(unsigned* bar, volatile LAS unsigned* st) {
    asm volatile("s_waitcnt vmcnt(0)" ::: "memory");
    __syncthreads();
    if (threadIdx.x == 0) {
        const unsigned x = xb_xcc_id();
        __builtin_amdgcn_s_waitcnt(0);
        unsigned nloc = st[0], nx = st[1];
        if (nloc == 0u) { xcd_barrier_complete(bar, x, nloc, nx); st[0] = nloc; st[1] = nx; }
        const unsigned old = xb_add(&bar[XB_XSUB(x)], 1u);
        const unsigned gen = old / nloc;
        if (old + 1u == (gen + 1u) * nloc) {
            __builtin_amdgcn_fence(__ATOMIC_RELEASE, "agent");
            asm volatile("s_waitcnt vmcnt(0)" ::: "memory");
            const unsigned og = xb_add(&bar[XB_TOP], 1u);
            const unsigned tg = og / nx;
            if (og + 1u == (tg + 1u) * nx) xb_add(&bar[XB_TOPGEN], 1u);
            else XB_SPIN(xb_ld(&bar[XB_TOPGEN]) == tg, bar);
            __builtin_amdgcn_fence(__ATOMIC_ACQUIRE, "agent");
            xb_add(&bar[XB_XGEN(x)], 1u);
            asm volatile("s_waitcnt vmcnt(0)" ::: "memory");
        } else {
            XB_SPIN(xb_ld(&bar[XB_XGEN(x)]) == gen, bar);
            __builtin_amdgcn_fence(__ATOMIC_ACQUIRE, "agent");
            asm volatile("s_waitcnt vmcnt(0)" ::: "memory");
        }
    }
    __syncthreads();
}

__global__ void __launch_bounds__(NTHR, 2) mega(Params p) {
    extern __shared__ __attribute__((aligned(16))) unsigned char lds_raw[];
    LAS unsigned char* lds = (LAS unsigned char*)lds_raw;
    cg::grid_group grid = cg::this_grid();
    const int tid = threadIdx.x, lane = tid & 63, wave = __builtin_amdgcn_readfirstlane(tid >> 6);
    const int G = gridDim.x, gw = blockIdx.x * NWAVE + wave, NGW = G * NWAVE;
    const size_t gtid = (size_t)blockIdx.x * NTHR + tid, NGT = (size_t)G * NTHR;
    {
        unsigned* bar = (unsigned*)(p.ws + WS_BAR);
        if (blockIdx.x == 0) for (int i = tid; i < XCD_BAR_WORDS; i += NTHR) __hip_atomic_store(bar + i, 0u, __ATOMIC_RELAXED, __HIP_MEMORY_SCOPE_AGENT);
        if (tid < 4) ((LAS unsigned*)(lds + LDS_XB))[tid] = 0u;
        __syncthreads();
    }
#define GBAR() xcd_barrier((unsigned*)(p.ws + WS_BAR), (volatile LAS unsigned*)(lds + LDS_XB))
#define W13 ((bf16_t*)(p.ws + WS_W13))
#define W2 ((bf16_t*)(p.ws + WS_W2))
#define WIN ((bf16_t*)(p.ws + WS_WIN))
#define WGLU ((bf16_t*)(p.ws + WS_WGLU))
#define WORET ((bf16_t*)(p.ws + WS_WORET))
#define WOUT ((bf16_t*)(p.ws + WS_WOUT))
#define WQ ((bf16_t*)(p.ws + WS_WQ))
#define WXO ((bf16_t*)(p.ws + WS_WXO))
#define WK ((bf16_t*)(p.ws + WS_WK))
#define WV ((bf16_t*)(p.ws + WS_WV))
#define HB ((bf16_t*)(p.ws + WS_HB))
#define RSTD ((float*)(p.ws + WS_RSTD))
#define PSS ((float*)(p.ws + WS_PSS))
#define RC ((float*)(p.ws + WS_ROPE))
#define BT2 ((bf16_t*)(p.ws + WS_BT2))
#define MB ((bf16_t*)(p.ws + WS_MB))
#define L16 ((float*)(p.ws + WS_L16))
#define GNS ((float*)(p.ws + WS_GNS))
#define MEMN ((bf16_t*)(p.ws + WS_MEMN))
#define KM ((bf16_t*)(p.ws + WS_KM))
#define VT ((bf16_t*)(p.ws + WS_VT))
#define ACT ((bf16_t*)(p.ws + WS_ACT))
#define U2 ((bf16_t*)(p.ws + WS_U2))
#define ACAT ((bf16_t*)(p.ws + WS_ACAT))
#define KB ((bf16_t*)(p.ws + WS_K))
#define KZT ((bf16_t*)(p.ws + WS_KZT))
#define BCAT ((bf16_t*)(p.ws + WS_BCAT))
#define OB ((bf16_t*)(p.ws + WS_O))
#define YA ((bf16_t*)(p.ws + WS_YA))
#define YB ((bf16_t*)(p.ws + WS_YB))
#define XL ((float*)(p.ws + WS_XL))
#define YACT ((bf16_t*)(p.ws + WS_YACT))
#define XQ ((bf16_t*)(p.ws + WS_XQ))
#define SC ((float*)(p.ws + WS_SC))
#define PB ((bf16_t*)(p.ws + WS_P))
#define XO ((bf16_t*)(p.ws + WS_XO))
#define RS (RC + 4096 * 128)
#define RCt (RC + 2 * 4096 * 128)
#define RSt (RC + 3 * 4096 * 128)
#define H (p.out)

    {
        for (size_t i = gtid; i < 128 * 256 / 2; i += NGT) ((unsigned*)(MB + (size_t)64 * 128 * 256))[i] = 0u;
        __syncthreads();
        for (size_t i = gtid; i < (size_t)4096 * 128; i += NGT) { const int l = (int)(i >> 7), k = (int)(i & 127);
            const float inv = powf(10000.0f, -(float)(2 * k) / 256.0f); const float ang = (float)l * inv; const float cs = (float)cos((double)ang), sn = (float)sin((double)ang);
            RC[i] = cs; RS[i] = sn; RCt[(size_t)k * 4096 + l] = cs; RSt[(size_t)k * 4096 + l] = sn; }
        for (int row = gw; row < T; row += NGW) { f32x4 v[8]; const float ss = row_sumsq_load(p.in[I_X] + (size_t)row * DM, lane, v);
            if (lane == 0) RSTD[row] = rsqrtf(ss * (1.0f / DM) + 1e-6f);
#pragma unroll
            for (int j = 0; j < 8; ++j) { u32x2 w; w.x = pk2(v[j][0], v[j][1]); w.y = pk2(v[j][2], v[j][3]); *(u32x2*)(HB + (size_t)row * DM + 4 * (lane + 64 * j)) = w; } }
        for (int row = gw; row < NB * MEML; row += NGW) { f32x4 v[8]; const float ss = row_sumsq_load(p.in[I_MEM] + (size_t)row * DM, lane, v); const float rs = rsqrtf(ss * (1.0f / DM) + 1e-6f);
#pragma unroll
            for (int j = 0; j < 8; ++j) { const f32x4 gn = *(const f32x4*)(p.in[I_MEMNRM] + 4 * (lane + 64 * j)); u32x2 w; w.x = pk2(v[j][0] * rs * gn[0], v[j][1] * rs * gn[1]); w.y = pk2(v[j][2] * rs * gn[2], v[j][3] * rs * gn[3]);
                *(u32x2*)(MEMN + (size_t)row * DM + 4 * (lane + 64 * j)) = w; } }
        convert_ffn(p, lds, I_F1W1, I_F1W3, I_F1W2, I_FFN1N, gw, NGW, wave, lane);
        { LAS float* scr = (LAS float*)(lds + wave * 16640);
          constexpr int NI = (2048 / 64) * (11264 / 64) + 2 * (1024 / 64) * (2048 / 64) + 6 * (2048 / 64) * (2048 / 64);
          for (int it = gw; it < NI; it += NGW) { int r = it;
              TMAT(p.in[I_WIN], 2048, 11264, WIN, 4, p.in[I_MIXN])
              TMAT(p.in[I_GLUV], 1024, 2048, WGLU, 1, (const float*)nullptr)
              TMAT(p.in[I_GLUG], 1024, 2048, WGLU, 2, (const float*)nullptr)
              TMAT(p.in[I_RETWO], 2048, 2048, WORET, 0, (const float*)nullptr)
              TMAT(p.in[I_WOUT], 2048, 2048, WOUT, 0, (const float*)nullptr)
              TMAT(p.in[I_XWQ], 2048, 2048, WQ, 0, p.in[I_XN])
              TMAT(p.in[I_XWK], 2048, 2048, WK, 0, (const float*)nullptr)
              TMAT(p.in[I_XWV], 2048, 2048, WV, 0, (const float*)nullptr)
              TMAT(p.in[I_XWO], 2048, 2048, WXO, 0, (const float*)nullptr)
          } }
        __syncthreads();
    }
    grid.sync();
    if (tid == 0) (void)xb_add(&((unsigned*)(p.ws + WS_BAR))[XB_XCNT(xb_xcc_id())], 1u);
    { JobFfnUp J{32, 2048, 2048, 2880, HB, W13, RSTD, ACT, MEMN, WK, WV, KM, VT}; gemm_phase(lds, J); }
    if (G == 256) { if (blockIdx.x >= 64) for (int it = blockIdx.x - 64; it < 256; it += 192) s5_prep_item(p, (LAS float*)lds, it & 63, it >> 6, tid); }
    else { for (int it = blockIdx.x; it < 256; it += G) s5_prep_item(p, (LAS float*)lds, it & 63, it >> 6, tid); }
    GBAR();
    { JobRes J{88, 5632, 5632, 512, ACT, W2, HB, PSS, 0.5f}; gemm_phase(lds, J, true); }
    GBAR();
    if (G == 256) {
        unsigned t0 = (unsigned)tid; asm volatile("" : "+v"(t0));
        if (t0 < 256u) { const unsigned r = (unsigned)(8 * (blockIdx.x & 7) + ((blockIdx.x >> 3) & 7)) * 256u + t0; float s = 0.f;
#pragma unroll
            for (int j = 0; j < 8; ++j) { const f32x4 v = *(const f32x4*)(PSS + (size_t)r * 32 + 4 * j); s += (v[0] + v[1]) + (v[2] + v[3]); }
            RSTD[r] = rsqrtf(s * (1.0f / DM) + 1e-6f); }
        asm volatile("s_waitcnt vmcnt(0)" ::: "memory"); __syncthreads();
    } else {
    { unsigned r0 = (unsigned)blockIdx.x * NTHR + (unsigned)tid; asm volatile("" : "+v"(r0));
      for (unsigned r = r0; r < (unsigned)T; r += (unsigned)G * NTHR) { float s = 0.f;
#pragma unroll
        for (int j = 0; j < 8; ++j) { const f32x4 v = *(const f32x4*)(PSS + (size_t)r * 32 + 4 * j); s += (v[0] + v[1]) + (v[2] + v[3]); }
        RSTD[r] = rsqrtf(s * (1.0f / DM) + 1e-6f); } }
        GBAR();
    }
    { JobWin1 J{32, 2048, 2048, 1280, HB, WIN, RSTD, RC, RS, RCt, RSt, U2, ACAT, KB, KZT, BCAT}; gemm_phase(lds, J, true); }
    GBAR();
    { JobScores J{4, 512, 1024, 256, ACAT, KB}; gemm_phase(lds, J); }
    { JobKV J{4, 512, 4096, 512, BCAT, KZT}; gemm_phase(lds, J); }
    { JobS5P1 J{4, 384, 256, 256, U2, MB, XL}; gemm_phase(lds, J); }
    GBAR();
    {
        for (int it = blockIdx.x; it < 256; it += G) { const int b = it >> 6, g = it & 63; const float ar = L16[(g * 64 + lane) * 2], ai = L16[(g * 64 + lane) * 2 + 1];
            const float* xl = XL + ((size_t)g * 1024 + b * 256 + 32 * wave) * 128 + lane; float lr[32], li[32], er[32], ei[32];
#pragma unroll
            for (int k = 0; k < 32; ++k) { lr[k] = xl[(size_t)k * 128]; li[k] = xl[(size_t)k * 128 + 64]; }
            float xr = 0.f, xi = 0.f;
#pragma unroll
            for (int k = 0; k < 32; ++k) { er[k] = xr; ei[k] = xi; const float nr = ar * xr - ai * xi + lr[k], ni = ar * xi + ai * xr + li[k]; xr = nr; xi = ni; }
            LAS float* sh = (LAS float*)lds; sh[(wave * 64 + lane) * 2] = xr; sh[(wave * 64 + lane) * 2 + 1] = xi;
            float qr = ar, qi = ai;
#pragma unroll
            for (int k = 0; k < 5; ++k) { const float t = qr * qr - qi * qi; qi = 2.f * qr * qi; qr = t; }
            __syncthreads();
            float cr = 0.f, ci = 0.f;
            for (int w2 = 0; w2 < wave; ++w2) { const float e0 = sh[(w2 * 64 + lane) * 2], e1 = sh[(w2 * 64 + lane) * 2 + 1]; const float t = qr * cr - qi * ci + e0; ci = qr * ci + qi * cr + e1; cr = t; }
            bf16_t* up = U2 + ((size_t)g * 1024 + b * 256 + 32 * wave) * 384 + 256 + lane; float pr = 1.f, pi = 0.f;
#pragma unroll
            for (int k = 0; k < 32; ++k) { const float vr = pr * cr - pi * ci + er[k], vi = pr * ci + pi * cr + ei[k];
                up[(size_t)k * 384] = (bf16_t)(pk2(vr, 0.f) & 0xffffu); up[(size_t)k * 384 + 64] = (bf16_t)(pk2(vi, 0.f) & 0xffffu);
                const float t = pr * ar - pi * ai; pi = pr * ai + pi * ar; pr = t; }
            __syncthreads();
        }
        for (size_t it = gtid; it < (size_t)16 * 512 * 32; it += NGT) { const int d8 = (int)(it & 31), e = (int)((it >> 5) & 511), bh = (int)(it >> 14);
            const float g256 = exp2f(256.0f * lgam(bh & 3)); f32x4 s0 = {0.f, 0.f, 0.f, 0.f}, s1 = s0;
            bf16_t* ptr = BCAT + ((size_t)(bh * 16) * 512 + e) * 512 + 256 + d8 * 8; u32x4 v[16];
#pragma unroll
            for (int c = 0; c < 16; ++c) v[c] = *(const u32x4*)(ptr + (size_t)c * 512 * 512);
#pragma unroll
            for (int c = 0; c < 16; ++c) { f32x4 a0, a1; unpk8(v[c], a0, a1); *(u32x4*)(ptr + (size_t)c * 512 * 512) = pk8(s0, s1); s0 = s0 * g256 + a0; s1 = s1 * g256 + a1; } }
    }
    GBAR();
    { JobRetOut J{8, 512, 512, 512, ACAT, BCAT, OB, (float*)(p.ws + WS_GNP)}; gemm_phase(lds, J); }
    { JobS5P2 J{6, 384, 384, 256, U2, BT2, YACT}; gemm_phase(lds, J); }
    GBAR();
    { JobGlu J{16, 1024, 1024, 1024, YACT, WGLU, YA}; gemm_phase(lds, J); }
    { JobGret J{32, 2048, 2048, 512, HB, WIN + (size_t)5120 * 2048, RSTD, (const float*)(p.ws + WS_GNP), OB}; gemm_phase(lds, J); }
    GBAR();
    { JobPlain J{32, 2048, 2048, 512, OB, WORET, YB, nullptr, 1.0f}; gemm_phase(lds, J, true); }
    if (G != 256) GBAR();
    { JobGate2 J{32, 2048, 2048, 1024, HB, WIN + (size_t)7168 * 2048, RSTD, YA, YB, G == 256 ? 1 : 0}; gemm_phase(lds, J); }
    GBAR();
    { JobRes J{32, 2048, 2048, 512, YA, WOUT, HB, PSS, 1.0f}; gemm_phase(lds, J, true); }
    GBAR();
    convert_ffn(p, lds, I_F2W1, I_F2W3, I_F2W2, I_FFN2N, gw, NGW, wave, lane);
    __syncthreads();
    if (G == 256) {
        unsigned t0 = (unsigned)tid; asm volatile("" : "+v"(t0));
        if (t0 < 256u) { const unsigned r = (unsigned)(8 * (blockIdx.x & 7) + ((blockIdx.x >> 3) & 7)) * 256u + t0; float s = 0.f;
#pragma unroll
            for (int j = 0; j < 8; ++j) { const f32x4 v = *(const f32x4*)(PSS + (size_t)r * 32 + 4 * j); s += (v[0] + v[1]) + (v[2] + v[3]); }
            RSTD[r] = rsqrtf(s * (1.0f / DM) + 1e-6f); }
        asm volatile("s_waitcnt vmcnt(0)" ::: "memory"); __syncthreads();
    } else {
    { unsigned r0 = (unsigned)blockIdx.x * NTHR + (unsigned)tid; asm volatile("" : "+v"(r0));
      for (unsigned r = r0; r < (unsigned)T; r += (unsigned)G * NTHR) { float s = 0.f;
#pragma unroll
        for (int j = 0; j < 8; ++j) { const f32x4 v = *(const f32x4*)(PSS + (size_t)r * 32 + 4 * j); s += (v[0] + v[1]) + (v[2] + v[3]); }
        RSTD[r] = rsqrtf(s * (1.0f / DM) + 1e-6f); } }
        GBAR();
    }
    { JobPlain J{32, 2048, 2048, 512, HB, WQ, XQ, RSTD, 0.04419417382415922f}; gemm_phase(lds, J, true); }
    GBAR();
    for (int base = 0; base < 256; base += G) { JobXs J{8, 2048, 2048, (256 - base) < G ? (256 - base) : G, XQ, KM, PB, base}; gemm_phase(lds, J); }
    GBAR();
    { JobPv J{4, 256, 256, 512, PB, VT, XO}; gemm_phase(lds, J); }
    GBAR();
    { JobRes J{32, 2048, 2048, 512, XO, WXO, HB, PSS, 1.0f}; gemm_phase(lds, J); }
    GBAR();
    if (G == 256) {
        unsigned t0 = (unsigned)tid; asm volatile("" : "+v"(t0));
        if (t0 < 256u) { const unsigned r = (unsigned)(8 * (blockIdx.x & 7) + ((blockIdx.x >> 3) & 7)) * 256u + t0; float s = 0.f;
#pragma unroll
            for (int j = 0; j < 8; ++j) { const f32x4 v = *(const f32x4*)(PSS + (size_t)r * 32 + 4 * j); s += (v[0] + v[1]) + (v[2] + v[3]); }
            RSTD[r] = rsqrtf(s * (1.0f / DM) + 1e-6f); }
        asm volatile("s_waitcnt vmcnt(0)" ::: "memory"); __syncthreads();
    } else {
    { unsigned r0 = (unsigned)blockIdx.x * NTHR + (unsigned)tid; asm volatile("" : "+v"(r0));
      for (unsigned r = r0; r < (unsigned)T; r += (unsigned)G * NTHR) { float s = 0.f;
#pragma unroll
        for (int j = 0; j < 8; ++j) { const f32x4 v = *(const f32x4*)(PSS + (size_t)r * 32 + 4 * j); s += (v[0] + v[1]) + (v[2] + v[3]); }
        RSTD[r] = rsqrtf(s * (1.0f / DM) + 1e-6f); } }
        GBAR();
    }
    { JobFfnUp J{32, 2048, 2048, 2816, HB, W13, RSTD, ACT, MEMN, WK, WV, KM, VT}; gemm_phase(lds, J, true); }
    GBAR();
    { JobRes J{88, 5632, 5632, 512, ACT, W2, HB, nullptr, 0.5f}; gemm_phase(lds, J, true); }
    GBAR();
    for (int row = gw; row < T; row += NGW) { f32x4 v[8]; float s = 0.f;
#pragma unroll
        for (int j = 0; j < 4; ++j) { unpk8(*(const u32x4*)(HB + (size_t)row * DM + 8 * (lane + 64 * j)), v[2 * j], v[2 * j + 1]);
            s += (v[2 * j][0] * v[2 * j][0] + v[2 * j][1] * v[2 * j][1]) + (v[2 * j][2] * v[2 * j][2] + v[2 * j][3] * v[2 * j][3]) + (v[2 * j + 1][0] * v[2 * j + 1][0] + v[2 * j + 1][1] * v[2 * j + 1][1]) + (v[2 * j + 1][2] * v[2 * j + 1][2] + v[2 * j + 1][3] * v[2 * j + 1][3]); }
        const float rs = rsqrtf(wave_sum(s) * (1.0f / DM) + 1e-6f);
#pragma unroll
        for (int j = 0; j < 4; ++j) { const int c0 = 8 * (lane + 64 * j); const f32x4 g0 = *(const f32x4*)(p.in[I_FINALN] + c0), g1 = *(const f32x4*)(p.in[I_FINALN] + c0 + 4);
            *(f32x4*)(H + (size_t)row * DM + c0) = v[2 * j] * rs * g0; *(f32x4*)(H + (size_t)row * DM + c0 + 4) = v[2 * j + 1] * rs * g1; } }
}

extern "C" void kernel_launch(void* const* d_in, const int* in_sizes, int n_in, void* d_out, int out_size, void* d_ws, size_t ws_size, hipStream_t stream) {
    static int grid = 0;
    if (grid == 0) {
        if (n_in != 31 || out_size != T * DM || ws_size < WS_END) { fprintf(stderr, "kernel_launch: unexpected problem (n_in %d, out %d, ws %zu < %zu)\n", n_in, out_size, ws_size, (size_t)WS_END); grid = -1; return; }
        int dev = 0, cus = 0, per_cu = 0;
        hipGetDevice(&dev); hipDeviceGetAttribute(&cus, hipDeviceAttributeMultiprocessorCount, dev);
        if (hipFuncSetAttribute((const void*)mega, hipFuncAttributeMaxDynamicSharedMemorySize, LDS_BYTES) != hipSuccess) { fprintf(stderr, "kernel_launch: hipFuncSetAttribute failed\n"); grid = -1; return; }
        if (hipOccupancyMaxActiveBlocksPerMultiprocessor(&per_cu, (const void*)mega, NTHR, LDS_BYTES) != hipSuccess || per_cu < 1) { fprintf(stderr, "kernel_launch: occupancy query says %d\n", per_cu); per_cu = 1; }
        (void)hipGetLastError();
        grid = cus * per_cu; if (grid > 256) grid = 256;
        fprintf(stderr, "kernel_launch: grid %d (cus %d x %d)\n", grid, cus, per_cu);
    }
    if (grid < 0) return;
    Params p{};
    for (int i = 0; i < 31; ++i) p.in[i] = (const float*)d_in[i];
    p.out = (float*)d_out; p.ws = (unsigned char*)d_ws;
    void* args[] = {&p};
    hipError_t e = hipLaunchCooperativeKernel((const void*)mega, dim3(grid), dim3(NTHR), args, LDS_BYTES, stream);
    if (e != hipSuccess) fprintf(stderr, "kernel_launch: cooperative launch failed: %s\n", hipGetErrorString(e));
}
```

```cpp
#include <hip/hip_runtime.h>
#include <hip/hip_cooperative_groups.h>
#include <cstdio>
#include <cstdint>
namespace cg = cooperative_groups;

#define LAS __attribute__((address_space(3)))
typedef unsigned short bf16_t;
typedef short bf16x8 __attribute__((ext_vector_type(8)));
typedef float f32x4 __attribute__((ext_vector_type(4)));
typedef unsigned u32x4 __attribute__((ext_vector_type(4)));
typedef unsigned u32x2 __attribute__((ext_vector_type(2)));

constexpr int DM = 2048, NB = 4, SEQ = 4096, T = NB * SEQ, FF = 5632, NIN = 11264, MEML = 256;
constexpr int NTHR = 512, NWAVE = 8;
constexpr int LDS_XB = 133120;
constexpr int LDS_BYTES = 133120 + 64;
constexpr float LG0 = -0.04580368961312479f, LG1 = -0.02272007650008353f, LG2 = -0.011315313227834146f, LG3 = -0.005646563141142063f;
__device__ __forceinline__ float lgam(int h) { return h == 0 ? LG0 : (h == 1 ? LG1 : (h == 2 ? LG2 : LG3)); }

constexpr size_t MiB = 1048576;
constexpr size_t WS_W13 = 0, WS_W2 = 44 * MiB, WS_WIN = 66 * MiB, WS_WGLU = 110 * MiB, WS_WORET = 118 * MiB, WS_WOUT = 126 * MiB, WS_WQ = 134 * MiB, WS_WXO = 142 * MiB;
constexpr size_t WS_HB = 150 * MiB;
constexpr size_t WS_SMALL = 214 * MiB;
constexpr size_t WS_RSTD = WS_SMALL;
constexpr size_t WS_PSS = WS_SMALL + 1 * MiB;
constexpr size_t WS_ROPE = WS_SMALL + 3 * MiB;
constexpr size_t WS_BT2 = WS_SMALL + 11 * MiB;
constexpr size_t WS_MB = WS_SMALL + 23 * MiB;
constexpr size_t WS_L16 = WS_SMALL + 28 * MiB;
constexpr size_t WS_GNS = WS_SMALL + 29 * MiB;
constexpr size_t WS_BAR = WS_SMALL + 29 * MiB + 768 * 1024;
constexpr size_t WS_MEMN = WS_SMALL + 30 * MiB;
constexpr size_t WS_KM = WS_SMALL + 34 * MiB;
constexpr size_t WS_VT = WS_SMALL + 38 * MiB;
constexpr size_t WS_MID = 256 * MiB;
constexpr size_t WS_ACT = WS_MID;
constexpr size_t WS_WK = WS_MID + 176 * MiB, WS_WV = WS_MID + 184 * MiB;
constexpr size_t WS_U2 = WS_MID;
constexpr size_t WS_ACAT = WS_MID + 48 * MiB;
constexpr size_t WS_K = WS_MID + 112 * MiB;
constexpr size_t WS_KZT = WS_MID + 144 * MiB;
constexpr size_t WS_BCAT = WS_MID + 176 * MiB;
constexpr size_t WS_O = WS_K;
constexpr size_t WS_YA = WS_ACAT;
constexpr size_t WS_YB = WS_BCAT;
constexpr size_t WS_XL = WS_W13;
constexpr size_t WS_YACT = WS_W13;
constexpr size_t WS_XQ = WS_BCAT;
constexpr size_t WS_SC = WS_BCAT + 64 * MiB;
constexpr size_t WS_P = WS_MID;
constexpr size_t WS_XO = WS_K;
constexpr size_t WS_GNP = WS_MID + 304 * MiB;
constexpr size_t WS_END = WS_MID + 308 * MiB;

struct Params {
    const float* in[31];
    float* out;
    unsigned char* ws;
};
enum { I_X = 0, I_MEM, I_FFN1N, I_F1W1, I_F1W3, I_F1W2, I_MIXN, I_WIN, I_ARE, I_AIM, I_LDT, I_BRE, I_BIM, I_CRE, I_CIM, I_S5D, I_GLUV, I_GLUG, I_RETWO, I_WOUT,
       I_XN, I_MEMNRM, I_XWQ, I_XWK, I_XWV, I_XWO, I_FFN2N, I_F2W1, I_F2W3, I_F2W2, I_FINALN };

__device__ __forceinline__ unsigned pk2(float lo, float hi) { unsigned r; asm("v_cvt_pk_bf16_f32 %0, %1, %2" : "=v"(r) : "v"(lo), "v"(hi)); return r; }
__device__ __forceinline__ float bflo(unsigned w) { return __uint_as_float(w << 16); }
__device__ __forceinline__ float bfhi(unsigned w) { return __uint_as_float(w & 0xffff0000u); }
__device__ __forceinline__ float sigm(float v) { return __builtin_amdgcn_rcpf(1.0f + __expf(-v)); }
__device__ __forceinline__ float wave_sum(float v) {
#pragma unroll
    for (int o = 1; o < 64; o <<= 1) v += __shfl_xor(v, o);
    return v;
}
__device__ __forceinline__ float wave_max(float v) {
#pragma unroll
    for (int o = 1; o < 64; o <<= 1) v = fmaxf(v, __shfl_xor(v, o));
    return v;
}
__device__ __forceinline__ u32x4 pk8(const f32x4 a, const f32x4 b) { u32x4 w; w.x = pk2(a[0], a[1]); w.y = pk2(a[2], a[3]); w.z = pk2(b[0], b[1]); w.w = pk2(b[2], b[3]); return w; }
__device__ __forceinline__ void unpk8(const u32x4 w, f32x4& a, f32x4& b) { a = (f32x4){bflo(w.x), bfhi(w.x), bflo(w.y), bfhi(w.y)}; b = (f32x4){bflo(w.z), bfhi(w.z), bflo(w.w), bfhi(w.w)}; }

constexpr int BM = 256, BK = 64, HALF = 128, HTB = HALF * BK * 2;
__device__ __forceinline__ int lds_byte(int r, int c) { const int st = (r >> 4) * 2 + (c >> 5), rr = r & 15, cc = c & 31, ob = rr * 64 + cc * 2; return st * 1024 + (ob ^ (((ob >> 9) & 1) << 5)); }
__device__ __forceinline__ void stage_rc(int b, int& R, int& C) { const int st = b / 1024, sb = b % 1024, swz = sb ^ (((sb >> 9) & 1) << 5); R = (st >> 1) * 16 + swz / 64; C = (st & 1) * 32 + (swz % 64) / 2; }
__device__ __forceinline__ int perm32(int rho) { const int n = rho >> 4, i = rho & 15; return 8 * (i >> 2) + 4 * n + (i & 3); }

struct Unit { int x, y, z; };
typedef f32x4 Acc[2][2][4][2];

__device__ __forceinline__ void tile_map(int L, int nM, int nN, int& pm, int& pn) {
    const int nwg = nM * nN; int wgid = L;
    { const int q = nwg >> 3, r = nwg & 7, xcd = wgid & 7, off = wgid >> 3; wgid = (xcd < r ? xcd * (q + 1) : r * (q + 1) + (xcd - r) * q) + off; }
    const int nig = 8 * nN, gid = wgid / nig, fm = gid * 8, gsz = (nM - fm) < 8 ? (nM - fm) : 8;
    pm = fm + ((wgid % nig) % gsz); pn = (wgid % nig) / gsz;
}

template <class Job> struct job_drain { static constexpr bool v = false; };
template <class Job>
__device__ __forceinline__ void gemm_phase(LAS unsigned char* lds, const Job& J, const bool rev0 = false) {
    const int tid = threadIdx.x, wid = __builtin_amdgcn_readfirstlane(tid >> 6), lane = tid & 63, wr = wid >> 2, wc = wid & 3, fr = lane & 15, fq = lane >> 4;
    const int nt = J.nt;
    const int G = gridDim.x, cblk = blockIdx.x;
    if (cblk >= J.nunits) return;
    unsigned voffA[2], voffB[2];
#pragma unroll
    for (int i = 0; i < 2; ++i) { int R, C; stage_rc(tid * 16 + i * 8192, R, C); const int Rb = (R & ~31) + perm32(R & 31);
        voffA[i] = (unsigned)(R * J.lda + C) * 2u; voffB[i] = (unsigned)(Rb * J.ldb + C) * 2u; }
    const long kfwd = (long)(BK * 2);
    long ks = rev0 ? -kfwd : kfwd;
    const size_t hstepA = (size_t)HALF * J.lda * 2, hstepB = (size_t)HALF * J.ldb * 2;
    const unsigned ldsw = (unsigned)wid * 1024u;
    const int aoff = lds_byte(wr * 64 + fr, fq * 8), boff = lds_byte(wc * 32 + fr, fq * 8);
#define PG8_SA(b, h) (((b) * 2 + (h)) * HTB)
#define PG8_SB(b, h) ((4 + (b) * 2 + (h)) * HTB)
#define PG8_STAGE(bufoff, gbase, voff) do { _Pragma("unroll") for (int _i = 0; _i < 2; ++_i) \
        __builtin_amdgcn_global_load_lds((const unsigned*)((const char*)(gbase) + (voff)[_i]), (LAS unsigned*)(lds + (bufoff) + ldsw + _i * 8192), 16, 0, 0); } while (0)
#define PG8_LDA(dst, b, h) do { _Pragma("unroll") for (int m = 0; m < 4; ++m) _Pragma("unroll") for (int k = 0; k < 2; ++k) dst[m][k] = *(const LAS bf16x8*)(lds + PG8_SA(b, h) + aoff + m * 2048 + k * 1024); } while (0)
#define PG8_LDB(dst, b, h) do { _Pragma("unroll") for (int n = 0; n < 2; ++n) _Pragma("unroll") for (int k = 0; k < 2; ++k) dst[n][k] = *(const LAS bf16x8*)(lds + PG8_SB(b, h) + boff + n * 2048 + k * 1024); } while (0)
#define PG8_MMA(ai, bj, At, Bt) do { __builtin_amdgcn_s_setprio(1); _Pragma("unroll") for (int m = 0; m < 4; ++m) _Pragma("unroll") for (int n = 0; n < 2; ++n) _Pragma("unroll") for (int k = 0; k < 2; ++k) \
        acc[ai][bj][m][n] = __builtin_amdgcn_mfma_f32_16x16x32_bf16(Bt[n][k], At[m][k], acc[ai][bj][m][n], 0, 0, 0); __builtin_amdgcn_s_setprio(0); } while (0)
#define PG8_WAIT_V(n) asm volatile("s_waitcnt vmcnt(" #n ")" ::: "memory")
#define PG8_WAIT_L(n) asm volatile("s_waitcnt lgkmcnt(" #n ")" ::: "memory")
#define PG8_BAR __builtin_amdgcn_s_barrier()
#define PG8_SCHED __builtin_amdgcn_sched_barrier(0)
    Unit cur, nxt; int ui = 0;
    const char* cA; const char* cB;
    J.get(cblk, cur, cA, cB);
    Acc acc;
#pragma unroll
    for (int a = 0; a < 2; ++a)
#pragma unroll
        for (int b = 0; b < 2; ++b)
#pragma unroll
            for (int m = 0; m < 4; ++m)
#pragma unroll
                for (int n = 0; n < 2; ++n) acc[a][b][m][n] = (f32x4){0.f, 0.f, 0.f, 0.f};
    bf16x8 At[4][2], B0[2][2], B1[2][2];
    if (rev0) { cA += (long)(nt - 1) * kfwd; cB += (long)(nt - 1) * kfwd; }
    PG8_STAGE(PG8_SB(0, 0), cB, voffB); PG8_STAGE(PG8_SB(0, 1), cB + hstepB, voffB); PG8_STAGE(PG8_SA(0, 0), cA, voffA); PG8_STAGE(PG8_SA(0, 1), cA + hstepA, voffA);
    if (wr == 1) PG8_BAR;
    PG8_WAIT_V(2); PG8_BAR;
    PG8_STAGE(PG8_SB(1, 0), cB + ks, voffB); PG8_STAGE(PG8_SA(1, 0), cA + ks, voffA); PG8_STAGE(PG8_SB(1, 1), cB + hstepB + ks, voffB);
    PG8_WAIT_V(6); PG8_BAR;
    for (;;) {
        const int Ln = (ui + 1) * G + cblk;
        const bool has_next = Ln < J.nunits;
        const char* nA; const char* nB; long ksN = ks;
        if (has_next) { J.get(Ln, nxt, nA, nB); ksN = -ks; if (ksN < 0) { nA += (long)(nt - 1) * kfwd; nB += (long)(nt - 1) * kfwd; } }
        else { nA = cA + (long)(nt - 2) * ks; nB = cB + (long)(nt - 2) * ks; }
        const char* pA = cA; const char* pB = cB;
        for (int t = 0; t < nt; t += 2) {
            const bool last = (t == nt - 2);
            const char* a1 = pA + ks;
            const char* a2 = last ? nA : pA + 2 * ks; const char* b2 = last ? nB : pB + 2 * ks;
            const long ks23 = last ? ksN : ks;
            const char* a3 = a2 + ks23; const char* b3 = b2 + ks23;
            pA += 2 * ks; pB += 2 * ks;
            PG8_LDB(B0, 0, 0); PG8_LDB(B1, 0, 1); PG8_SCHED; PG8_LDA(At, 0, 0); PG8_STAGE(PG8_SA(1, 1), a1 + hstepA, voffA);
            PG8_WAIT_V(8); PG8_WAIT_L(0); PG8_BAR; PG8_MMA(0, 0, At, B0); PG8_MMA(0, 1, At, B1); PG8_BAR; PG8_SCHED;
            PG8_LDA(At, 0, 1); PG8_STAGE(PG8_SB(0, 0), b2, voffB); PG8_STAGE(PG8_SB(0, 1), b2 + hstepB, voffB); PG8_STAGE(PG8_SA(0, 0), a2, voffA);
            PG8_WAIT_V(8); PG8_WAIT_L(0); PG8_BAR; PG8_MMA(1, 0, At, B0); PG8_MMA(1, 1, At, B1); PG8_BAR; PG8_SCHED;
            PG8_LDB(B0, 1, 0); PG8_LDB(B1, 1, 1); PG8_SCHED; PG8_LDA(At, 1, 0); PG8_STAGE(PG8_SA(0, 1), a2 + hstepA, voffA);
            PG8_WAIT_V(8); PG8_WAIT_L(0); PG8_BAR; PG8_MMA(0, 0, At, B0); PG8_MMA(0, 1, At, B1); PG8_BAR; PG8_SCHED;
            PG8_LDA(At, 1, 1); PG8_STAGE(PG8_SB(1, 0), b3, voffB); PG8_STAGE(PG8_SB(1, 1), b3 + hstepB, voffB); PG8_STAGE(PG8_SA(1, 0), a3, voffA);
            PG8_WAIT_V(8); PG8_WAIT_L(0); PG8_BAR; PG8_MMA(1, 0, At, B0); PG8_MMA(1, 1, At, B1); PG8_BAR; PG8_SCHED;
        }
        if (wr == 0) PG8_BAR;
        { int frl = fr, fql = fq, wrl = wr, wcl = wc; asm volatile("" : "+v"(frl), "+v"(fql), "+s"(wrl), "+s"(wcl));
          if constexpr (!job_drain<Job>::v) J.epi(acc, cur, wrl, wcl, frl, fql); }
        if (!has_next) break;
#pragma unroll
        for (int a = 0; a < 2; ++a)
#pragma unroll
            for (int b = 0; b < 2; ++b)
#pragma unroll
                for (int m = 0; m < 4; ++m)
#pragma unroll
                    for (int n = 0; n < 2; ++n) acc[a][b][m][n] = (f32x4){0.f, 0.f, 0.f, 0.f};
        cur = nxt; cA = nA; cB = nB; ks = ksN; ++ui;
        if (wr == 1) PG8_BAR;
    }
    PG8_WAIT_V(0);
    PG8_BAR;
    if constexpr (job_drain<Job>::v) J.epi_drain(acc, cur, lds, wr, wc, fr, fq);
#undef PG8_SA
#undef PG8_SB
#undef PG8_STAGE
#undef PG8_LDA
#undef PG8_LDB
#undef PG8_MMA
#undef PG8_WAIT_V
#undef PG8_WAIT_L
#undef PG8_BAR
#undef PG8_SCHED
}

__device__ __forceinline__ void store_tile_bf16(const Acc& acc, bf16_t* base, size_t ld, int wr, int wc, int fr, int fq, float sc) {
#pragma unroll
    for (int ai = 0; ai < 2; ++ai)
#pragma unroll
        for (int m = 0; m < 4; ++m) { bf16_t* rowp = base + (size_t)(128 * ai + 64 * wr + 16 * m + fr) * ld + 32 * wc + 8 * fq;
#pragma unroll
            for (int bj = 0; bj < 2; ++bj) *(u32x4*)(rowp + 128 * bj) = pk8(acc[ai][bj][m][0] * sc, acc[ai][bj][m][1] * sc); }
}

struct JobFfnUp {
    int nt, lda, ldb, nunits;
    const bf16_t* A; const bf16_t* W13; const float* rstd; bf16_t* act;
    const bf16_t* memn; const bf16_t* Wk; const bf16_t* Wv; bf16_t* KM; bf16_t* VT;
    __device__ __forceinline__ void get(int L, Unit& u, const char*& uA, const char*& uB) const {
        if (L < 2816) { int pm, pn; tile_map(L, 64, 44, pm, pn); uA = (const char*)(A + (size_t)pm * 256 * 2048); uB = (const char*)(W13 + (size_t)pn * 256 * 2048); u.x = pm; u.y = pn; u.z = 0; }
        else { const int i = L - 2816;
            if (i < 32) { const int pm = i >> 3, pn = i & 7; uA = (const char*)(memn + (size_t)pm * 256 * 2048); uB = (const char*)(Wk + (size_t)pn * 256 * 2048); u.x = pm; u.y = pn; u.z = 1; }
            else { const int k = i - 32, pm = k >> 2, pn = k & 3; uA = (const char*)(Wv + (size_t)pm * 256 * 2048); uB = (const char*)(memn + (size_t)pn * 256 * 2048); u.x = pm; u.y = pn; u.z = 2; } }
    }
    __device__ __forceinline__ void epi(Acc& acc, const Unit& u, int wr, int wc, int fr, int fq) const {
        if (u.z == 0) {
#pragma unroll
            for (int ai = 0; ai < 2; ++ai)
#pragma unroll
                for (int m = 0; m < 4; ++m) { const int r = u.x * 256 + 128 * ai + 64 * wr + 16 * m + fr; const float rs = rstd[r];
                    f32x4 o[2];
#pragma unroll
                    for (int n = 0; n < 2; ++n)
#pragma unroll
                        for (int j = 0; j < 4; ++j) { const float z1 = acc[ai][0][m][n][j] * rs, z3 = acc[ai][1][m][n][j] * rs; o[n][j] = z1 * sigm(z1) * z3; }
                    *(u32x4*)(act + (size_t)r * FF + u.y * 128 + 32 * wc + 8 * fq) = pk8(o[0], o[1]); }
        } else if (u.z == 1) { store_tile_bf16(acc, KM + (size_t)u.x * 256 * 2048 + u.y * 256, 2048, wr, wc, fr, fq, 1.0f); }
        else { store_tile_bf16(acc, VT + ((size_t)u.y * 2048 + u.x * 256) * 256, 256, wr, wc, fr, fq, 1.0f); }
    }
};

struct JobRes {
    int nt, lda, ldb, nunits;
    const bf16_t* A; const bf16_t* W; bf16_t* hb; float* pss; float scale;
    __device__ __forceinline__ void get(int L, Unit& u, const char*& uA, const char*& uB) const { int pm, pn; tile_map(L, 64, 8, pm, pn); uA = (const char*)(A + (size_t)pm * 256 * lda); uB = (const char*)(W + (size_t)pn * 256 * ldb); u.x = pm; u.y = pn; u.z = 0; }
    __device__ __forceinline__ void epi(Acc& acc, const Unit& u, int wr, int wc, int fr, int fq) const {
#pragma unroll
        for (int ai = 0; ai < 2; ++ai) {
            u32x4 rr[4][2];
#pragma unroll
            for (int m = 0; m < 4; ++m) { const size_t off = (size_t)(u.x * 256 + 128 * ai + 64 * wr + 16 * m + fr) * DM + u.y * 256 + 32 * wc + 8 * fq;
#pragma unroll
                for (int bj = 0; bj < 2; ++bj) rr[m][bj] = *(const u32x4*)(hb + off + 128 * bj); }
            asm volatile("" ::: "memory");
#pragma unroll
            for (int m = 0; m < 4; ++m) { const int r = u.x * 256 + 128 * ai + 64 * wr + 16 * m + fr; const size_t off = (size_t)r * DM + u.y * 256 + 32 * wc + 8 * fq; float ss = 0.f;
#pragma unroll
                for (int bj = 0; bj < 2; ++bj) { f32x4 r0, r1; unpk8(rr[m][bj], r0, r1); const f32x4 h0 = r0 + acc[ai][bj][m][0] * scale, h1 = r1 + acc[ai][bj][m][1] * scale;
                    *(u32x4*)(hb + off + 128 * bj) = pk8(h0, h1);
                    ss += (h0[0] * h0[0] + h0[1] * h0[1]) + (h0[2] * h0[2] + h0[3] * h0[3]) + (h1[0] * h1[0] + h1[1] * h1[1]) + (h1[2] * h1[2] + h1[3] * h1[3]); }
                if (pss) { ss += __shfl_xor(ss, 16); ss += __shfl_xor(ss, 32); if (fq == 0) pss[(size_t)r * 32 + u.y * 4 + wc] = ss; } }
            asm volatile("" ::: "memory");
        }
    }
};
struct JobWin1 {
    int nt, lda, ldb, nunits;
    const bf16_t* HB; const bf16_t* Win; const float* rstd; const float* RC; const float* RS; const float* RCt; const float* RSt;
    bf16_t* U2; bf16_t* Acat; bf16_t* Kb; bf16_t* KzT; bf16_t* Bcat;
    __device__ __forceinline__ void get(int L, Unit& u, const char*& uA, const char*& uB) const {
        if (L < 768) { int pm, pn; tile_map(L, 64, 12, pm, pn); uA = (const char*)(HB + (size_t)pm * 256 * 2048); uB = (const char*)(Win + (size_t)pn * 256 * 2048); u.x = pm; u.y = pn; u.z = 0; }
        else { int pm, pn; tile_map(L - 768, 8, 64, pm, pn); uA = (const char*)(Win + (size_t)(3072 + pm * 256) * 2048); uB = (const char*)(HB + (size_t)pn * 256 * 2048); u.x = pm; u.y = pn; u.z = 1; }
    }
    __device__ __forceinline__ void epi(Acc& acc, const Unit& u, int wr, int wc, int fr, int fq) const {
        if (u.z == 0) {
            const int b = u.x >> 4;
            if (u.y < 4) {
#pragma unroll
                for (int ai = 0; ai < 2; ++ai)
#pragma unroll
                    for (int m = 0; m < 4; ++m) { const int r = u.x * 256 + 128 * ai + 64 * wr + 16 * m + fr; const float rs = rstd[r]; const int l = r & 4095, c = l >> 4, jj = l & 15;
#pragma unroll
                        for (int bj = 0; bj < 2; ++bj) { const int col = u.y * 256 + 128 * bj + 32 * wc + 8 * fq, g = col >> 4, ci0 = col & 15;
                            *(u32x4*)(U2 + ((size_t)g * 1024 + b * 256 + c) * 384 + jj * 16 + ci0) = pk8(acc[ai][bj][m][0] * rs, acc[ai][bj][m][1] * rs); } }
            } else {
                const bool isq = u.y < 8; const int h = (u.y - 4) & 3; const float lg = lgam(h);
                float rsv[2][4];
#pragma unroll
                for (int ai = 0; ai < 2; ++ai)
#pragma unroll
                    for (int m = 0; m < 4; ++m) rsv[ai][m] = rstd[u.x * 256 + 128 * ai + 64 * wr + 16 * m + fr];
#pragma unroll
                for (int ai = 0; ai < 2; ++ai)
#pragma unroll
                    for (int m = 0; m < 4; ++m) { const int r = u.x * 256 + 128 * ai + 64 * wr + 16 * m + fr; const int l = r & 4095; const int i0 = 32 * wc + 8 * fq;
                        float rs = rsv[ai][m];
                        if (isq) rs *= exp2f((float)((l & 255) + 1) * lg); else rs = rs * rs * 0.0625f;
                        f32x4 o1[2], o2[2];
#pragma unroll
                        for (int n = 0; n < 2; ++n) { const f32x4 cs = *(const f32x4*)(RC + (size_t)l * 128 + i0 + 4 * n), sn = *(const f32x4*)(RS + (size_t)l * 128 + i0 + 4 * n);
                            const f32x4 t1 = acc[ai][0][m][n] * rs, t2 = acc[ai][1][m][n] * rs; o1[n] = t1 * cs - t2 * sn; o2[n] = t1 * sn + t2 * cs; }
                        if (isq) { bf16_t* dst = Acat + ((size_t)((b * 4 + h) * 16 + (l >> 8)) * 256 + (l & 255)) * 512 + 256 + i0;
                            *(u32x4*)dst = pk8(o1[0], o1[1]); *(u32x4*)(dst + 128) = pk8(o2[0], o2[1]); }
                        else { bf16_t* dst = Kb + (size_t)r * 1024 + h * 256 + i0; *(u32x4*)dst = pk8(o1[0], o1[1]); *(u32x4*)(dst + 128) = pk8(o2[0], o2[1]);
                            const float zt = exp2f((float)(255 - (l & 255)) * lg);
                            bf16_t* kz = KzT + ((size_t)(b * 4 + h) * 256 + i0) * 4096 + l;
#pragma unroll
                            for (int n = 0; n < 2; ++n)
#pragma unroll
                                for (int j = 0; j < 4; ++j) { kz[(size_t)(4 * n + j) * 4096] = (bf16_t)(pk2(o1[n][j] * zt, 0.f) & 0xffffu); kz[(size_t)(128 + 4 * n + j) * 4096] = (bf16_t)(pk2(o2[n][j] * zt, 0.f) & 0xffffu); } }
                        asm volatile("" ::: "memory"); }
            }
        } else {
            const int b = u.y >> 4, lbase = (u.y & 15) * 256;
            {
                const int vt = u.x, h = vt >> 1, e0 = (vt & 1) * 256, c = u.y & 15;
                bf16_t* base = Bcat + ((size_t)((b * 4 + h) * 16 + c) * 512 + e0) * 512;
#pragma unroll
                for (int bj = 0; bj < 2; ++bj) { const int lc = 128 * bj + 32 * wc + 8 * fq;
#pragma unroll
                    for (int ai = 0; ai < 2; ++ai)
#pragma unroll
                        for (int m = 0; m < 4; ++m) *(u32x4*)(base + (size_t)(128 * ai + 64 * wr + 16 * m + fr) * 512 + lc) = pk8(acc[ai][bj][m][0], acc[ai][bj][m][1]); }
            }
        }
    }
};

struct JobScores {
    int nt, lda, ldb, nunits; bf16_t* Acat; const bf16_t* Kb;
    __device__ __forceinline__ void get(int L, Unit& u, const char*& uA, const char*& uB) const { const int bh = L >> 4, c = L & 15, b = bh >> 2, h = bh & 3;
        uA = (const char*)(Acat + (size_t)L * 256 * 512 + 256); uB = (const char*)(Kb + ((size_t)(b * 4096 + c * 256)) * 1024 + h * 256); u.x = L; u.y = h; u.z = 0; }
    __device__ __forceinline__ void epi(Acc& acc, const Unit& u, int wr, int wc, int fr, int fq) const {
        const float lg = lgam(u.y); bf16_t* base = Acat + (size_t)u.x * 256 * 512;
#pragma unroll
        for (int bj = 0; bj < 2; ++bj) { const int jc = 128 * bj + 32 * wc + 8 * fq; f32x4 w[2];
#pragma unroll
            for (int n = 0; n < 2; ++n)
#pragma unroll
                for (int j = 0; j < 4; ++j) w[n][j] = exp2f(-(float)(jc + 4 * n + j + 1) * lg);
#pragma unroll
            for (int ai = 0; ai < 2; ++ai)
#pragma unroll
                for (int m = 0; m < 4; ++m) { const int i = 128 * ai + 64 * wr + 16 * m + fr; f32x4 o[2];
#pragma unroll
                    for (int n = 0; n < 2; ++n)
#pragma unroll
                        for (int j = 0; j < 4; ++j) { const unsigned msk = (unsigned)((jc + 4 * n + j - i - 1) >> 31);
                            o[n][j] = __uint_as_float(__float_as_uint(acc[ai][bj][m][n][j] * w[n][j]) & msk); }
                    *(u32x4*)(base + (size_t)i * 512 + jc) = pk8(o[0], o[1]); asm volatile("" ::: "memory"); } }
    }
};
struct JobKV {
    int nt, lda, ldb, nunits; bf16_t* Bcat; const bf16_t* KzT;
    __device__ __forceinline__ void get(int L, Unit& u, const char*& uA, const char*& uB) const { const int bhc = L >> 1, et = L & 1, bh = bhc >> 4, c = bhc & 15;
        uA = (const char*)(Bcat + ((size_t)bhc * 512 + et * 256) * 512); uB = (const char*)(KzT + (size_t)bh * 256 * 4096 + c * 256); u.x = bhc; u.y = et; u.z = 0; }
    __device__ __forceinline__ void epi(Acc& acc, const Unit& u, int wr, int wc, int fr, int fq) const {
        store_tile_bf16(acc, Bcat + ((size_t)u.x * 512 + u.y * 256) * 512 + 256, 512, wr, wc, fr, fq, 1.0f); }
};
struct JobS5P1 {
    int nt, lda, ldb, nunits; const bf16_t* U2; const bf16_t* MB; float* XL;
    __device__ __forceinline__ void get(int L, Unit& u, const char*& uA, const char*& uB) const { const int g = L >> 2, b = L & 3;
        uA = (const char*)(U2 + ((size_t)g * 1024 + b * 256) * 384); uB = (const char*)(MB + (size_t)g * 128 * 256); u.x = g; u.y = b; u.z = 0; }
    __device__ __forceinline__ void epi(Acc& acc, const Unit& u, int wr, int wc, int fr, int fq) const {
#pragma unroll
        for (int ai = 0; ai < 2; ++ai)
#pragma unroll
            for (int m = 0; m < 4; ++m) { float* p = XL + ((size_t)u.x * 1024 + u.y * 256 + 128 * ai + 64 * wr + 16 * m + fr) * 128 + 32 * wc + 8 * fq;
                *(f32x4*)p = acc[ai][0][m][0]; *(f32x4*)(p + 4) = acc[ai][0][m][1]; }
    }
};
struct JobRetOut {
    int nt, lda, ldb, nunits; const bf16_t* Acat; const bf16_t* Bcat; bf16_t* O; float* GNP;
    __device__ __forceinline__ void get(int L, Unit& u, const char*& uA, const char*& uB) const { const int bhc = L >> 1, et = L & 1;
        uA = (const char*)(Acat + (size_t)bhc * 256 * 512); uB = (const char*)(Bcat + ((size_t)bhc * 512 + et * 256) * 512); u.x = bhc; u.y = et; u.z = 0; }
    __device__ __forceinline__ void epi(Acc& acc, const Unit& u, int wr, int wc, int fr, int fq) const { const int bh = u.x >> 4, c = u.x & 15, b = bh >> 2, h = bh & 3;
        store_tile_bf16(acc, O + (size_t)(b * 4096 + c * 256) * 2048 + h * 512 + u.y * 256, 2048, wr, wc, fr, fq, 1.0f);
#pragma unroll
        for (int ai = 0; ai < 2; ++ai)
#pragma unroll
            for (int m = 0; m < 4; ++m) { float s1 = 0.f, s2 = 0.f;
#pragma unroll
                for (int bj = 0; bj < 2; ++bj)
#pragma unroll
                    for (int n = 0; n < 2; ++n) { const f32x4 v = acc[ai][bj][m][n]; s1 += (v[0] + v[1]) + (v[2] + v[3]); s2 += (v[0] * v[0] + v[1] * v[1]) + (v[2] * v[2] + v[3] * v[3]); }
                s1 += __shfl_xor(s1, 16); s1 += __shfl_xor(s1, 32); s2 += __shfl_xor(s2, 16); s2 += __shfl_xor(s2, 32);
                if (fq == 0) { const int tok = b * 4096 + c * 256 + 128 * ai + 64 * wr + 16 * m + fr; float* g = GNP + (((size_t)tok * 4 + h) * 8 + u.y * 4 + wc) * 2; g[0] = s1; g[1] = s2; } }
    }
};
struct JobS5P2 {
    int nt, lda, ldb, nunits; const bf16_t* U2; const bf16_t* BT2; bf16_t* Yact;
    __device__ __forceinline__ void get(int L, Unit& u, const char*& uA, const char*& uB) const { const int g = L >> 2, b = L & 3;
        uA = (const char*)(U2 + ((size_t)g * 1024 + b * 256) * 384); uB = (const char*)(BT2 + (size_t)g * 256 * 384); u.x = g; u.y = b; u.z = 0; }
    __device__ __forceinline__ void epi(Acc& acc, const Unit& u, int wr, int wc, int fr, int fq) const {
#pragma unroll
        for (int ai = 0; ai < 2; ++ai)
#pragma unroll
            for (int m = 0; m < 4; ++m) { const int c = 128 * ai + 64 * wr + 16 * m + fr;
#pragma unroll
                for (int bj = 0; bj < 2; ++bj) { const int col = 128 * bj + 32 * wc + 8 * fq, t = col >> 4, ch0 = col & 15; f32x4 o[2];
#pragma unroll
                    for (int n = 0; n < 2; ++n)
#pragma unroll
                        for (int j = 0; j < 4; ++j) { const float y = acc[ai][bj][m][n][j]; o[n][j] = y * sigm(1.5957691216f * (y + 0.044715f * y * y * y)); }
                    *(u32x4*)(Yact + (size_t)(u.y * 4096 + c * 16 + t) * 1024 + u.x * 16 + ch0) = pk8(o[0], o[1]); } }
    }
};
struct JobGret {
    int nt, lda, ldb, nunits; const bf16_t* HB; const bf16_t* W; const float* rstd; const float* GNS; bf16_t* O;
    __device__ __forceinline__ void get(int L, Unit& u, const char*& uA, const char*& uB) const { int pm, pn; tile_map(L, 64, 8, pm, pn); uA = (const char*)(HB + (size_t)pm * 256 * 2048); uB = (const char*)(W + (size_t)pn * 256 * 2048); u.x = pm; u.y = pn; u.z = 0; }
    __device__ __forceinline__ void epi(Acc& acc, const Unit& u, int wr, int wc, int fr, int fq) const {
#pragma unroll
        for (int aq = 0; aq < 4; ++aq) { const int ai = aq >> 1, m0 = (aq & 1) * 2;
            f32x4 gs[4][4]; u32x4 ov[4][2]; float rsv[4];
#pragma unroll
            for (int m = m0; m < m0 + 2; ++m) { const int r = u.x * 256 + 128 * ai + 64 * wr + 16 * m + fr; rsv[m] = rstd[r];
                const f32x4* g = (const f32x4*)(GNS + ((size_t)r * 4 + (u.y >> 1)) * 16); gs[m][0] = g[0]; gs[m][1] = g[1]; gs[m][2] = g[2]; gs[m][3] = g[3];
#pragma unroll
                for (int bj = 0; bj < 2; ++bj) ov[m][bj] = *(const u32x4*)(O + (size_t)r * 2048 + u.y * 256 + 128 * bj + 32 * wc + 8 * fq); }
            asm volatile("" ::: "memory");
#pragma unroll
            for (int m = m0; m < m0 + 2; ++m) { const int r = u.x * 256 + 128 * ai + 64 * wr + 16 * m + fr; const float rs = rsv[m];
                const f32x4 a = gs[m][0], bq = gs[m][1], cq = gs[m][2], d = gs[m][3];
                const float s1 = (a[0] + a[2]) + (bq[0] + bq[2]) + (cq[0] + cq[2]) + (d[0] + d[2]), s2 = (a[1] + a[3]) + (bq[1] + bq[3]) + (cq[1] + cq[3]) + (d[1] + d[3]);
                const float mean = s1 * (1.0f / 512.0f), grs = rsqrtf(fmaxf(s2 * (1.0f / 512.0f) - mean * mean, 0.f) + 1e-5f);
#pragma unroll
                for (int bj = 0; bj < 2; ++bj) { bf16_t* p = O + (size_t)r * 2048 + u.y * 256 + 128 * bj + 32 * wc + 8 * fq; f32x4 o0, o1; unpk8(ov[m][bj], o0, o1);
#pragma unroll
                    for (int j = 0; j < 4; ++j) { const float g0 = acc[ai][bj][m][0][j] * rs, g1 = acc[ai][bj][m][1][j] * rs; o0[j] = g0 * sigm(g0) * (o0[j] - mean) * grs; o1[j] = g1 * sigm(g1) * (o1[j] - mean) * grs; }
                    *(u32x4*)p = pk8(o0, o1); } }
            asm volatile("" ::: "memory");
        }
    }
};
struct JobGlu {
    int nt, lda, ldb, nunits; const bf16_t* Yact; const bf16_t* W; bf16_t* YA;
    __device__ __forceinline__ void get(int L, Unit& u, const char*& uA, const char*& uB) const { int pm, pn; tile_map(L, 64, 16, pm, pn); uA = (const char*)(Yact + (size_t)pm * 256 * 1024); uB = (const char*)(W + (size_t)pn * 256 * 1024); u.x = pm; u.y = pn; u.z = 0; }
    __device__ __forceinline__ void epi(Acc& acc, const Unit& u, int wr, int wc, int fr, int fq) const {
#pragma unroll
        for (int ai = 0; ai < 2; ++ai)
#pragma unroll
            for (int m = 0; m < 4; ++m) { const int r = u.x * 256 + 128 * ai + 64 * wr + 16 * m + fr; f32x4 o[2];
#pragma unroll
                for (int n = 0; n < 2; ++n)
#pragma unroll
                    for (int j = 0; j < 4; ++j) o[n][j] = acc[ai][0][m][n][j] * sigm(acc[ai][1][m][n][j]);
                *(u32x4*)(YA + (size_t)r * 2048 + u.y * 128 + 32 * wc + 8 * fq) = pk8(o[0], o[1]); }
    }
};
struct JobPlain {
    int nt, lda, ldb, nunits; const bf16_t* A; const bf16_t* W; bf16_t* out; const float* rstd; float sc;
    __device__ __forceinline__ void get(int L, Unit& u, const char*& uA, const char*& uB) const { int pm, pn; tile_map(L, 64, 8, pm, pn); uA = (const char*)(A + (size_t)pm * 256 * 2048); uB = (const char*)(W + (size_t)pn * 256 * 2048); u.x = pm; u.y = pn; u.z = 0; }
    __device__ __forceinline__ void epi(Acc& acc, const Unit& u, int wr, int wc, int fr, int fq) const {
#pragma unroll
        for (int ai = 0; ai < 2; ++ai)
#pragma unroll
            for (int m = 0; m < 4; ++m) { const int r = u.x * 256 + 128 * ai + 64 * wr + 16 * m + fr; const float s = rstd ? rstd[r] * sc : sc;
#pragma unroll
                for (int bj = 0; bj < 2; ++bj) *(u32x4*)(out + (size_t)r * 2048 + u.y * 256 + 128 * bj + 32 * wc + 8 * fq) = pk8(acc[ai][bj][m][0] * s, acc[ai][bj][m][1] * s); }
    }
};
struct JobGate {
    int nt, lda, ldb, nunits; const bf16_t* HB; const bf16_t* W; const float* rstd; bf16_t* YA; const bf16_t* YB; int mode;
    __device__ __forceinline__ void get(int L, Unit& u, const char*& uA, const char*& uB) const { int pm, pn; tile_map(L, 64, 8, pm, pn); uA = (const char*)(HB + (size_t)pm * 256 * 2048); uB = (const char*)(W + (size_t)pn * 256 * 2048); u.x = pm; u.y = pn; u.z = 0; }
    __device__ __forceinline__ void epi(Acc& acc, const Unit& u, int wr, int wc, int fr, int fq) const {
#pragma unroll
        for (int aq = 0; aq < 4; ++aq) { const int ai = aq >> 1, m0 = (aq & 1) * 2;
            u32x4 av[4][2], bv[4][2]; float rsv[4];
#pragma unroll
            for (int m = m0; m < m0 + 2; ++m) { const int r = u.x * 256 + 128 * ai + 64 * wr + 16 * m + fr; rsv[m] = rstd[r];
#pragma unroll
                for (int bj = 0; bj < 2; ++bj) { const size_t off = (size_t)r * 2048 + u.y * 256 + 128 * bj + 32 * wc + 8 * fq; av[m][bj] = *(const u32x4*)(YA + off); bv[m][bj] = mode ? *(const u32x4*)(YB + off) : (u32x4){0u, 0u, 0u, 0u}; } }
            asm volatile("" ::: "memory");
#pragma unroll
            for (int m = m0; m < m0 + 2; ++m) { const int r = u.x * 256 + 128 * ai + 64 * wr + 16 * m + fr; const float rs = rsv[m];
#pragma unroll
                for (int bj = 0; bj < 2; ++bj) { const size_t off = (size_t)r * 2048 + u.y * 256 + 128 * bj + 32 * wc + 8 * fq; f32x4 a0, a1; unpk8(av[m][bj], a0, a1);
                    if (mode == 0) {
#pragma unroll
                        for (int j = 0; j < 4; ++j) { a0[j] *= sigm(acc[ai][bj][m][0][j] * rs); a1[j] *= sigm(acc[ai][bj][m][1][j] * rs); }
                    } else { f32x4 b0, b1; unpk8(bv[m][bj], b0, b1);
#pragma unroll
                        for (int j = 0; j < 4; ++j) { a0[j] += sigm(acc[ai][bj][m][0][j] * rs) * b0[j]; a1[j] += sigm(acc[ai][bj][m][1][j] * rs) * b1[j]; } }
                    *(u32x4*)(YA + off) = pk8(a0, a1); } }
            asm volatile("" ::: "memory");
        }
    }
};
struct JobGate2 {
    int nt, lda, ldb, nunits; const bf16_t* HB; const bf16_t* W; const float* rstd; bf16_t* YA; const bf16_t* YB; int own;
    __device__ __forceinline__ void get(int L, Unit& u, const char*& uA, const char*& uB) const { int pm, pn;
        if (own) { const int c = L & 255, i = L >> 8; pm = 8 * (c & 7) + ((c >> 3) & 7); pn = 2 * ((c >> 6) + 4 * (i >> 1)) + (i & 1); } else tile_map(L, 64, 16, pm, pn);
        uA = (const char*)(HB + (size_t)pm * 256 * 2048); uB = (const char*)(W + (size_t)pn * 256 * 2048); u.x = pm; u.y = pn; u.z = 0; }
    __device__ __forceinline__ void epi(Acc& acc, const Unit& u, int wr, int wc, int fr, int fq) const {
#pragma unroll
        for (int ai = 0; ai < 2; ++ai) {
            u32x4 av[4], bv[4]; float rsv[4];
#pragma unroll
            for (int m = 0; m < 4; ++m) { const int r = u.x * 256 + 128 * ai + 64 * wr + 16 * m + fr; rsv[m] = rstd[r];
                const size_t off = (size_t)r * 2048 + u.y * 128 + 32 * wc + 8 * fq; av[m] = *(const u32x4*)(YA + off); bv[m] = *(const u32x4*)(YB + off); }
            asm volatile("" ::: "memory");
#pragma unroll
            for (int m = 0; m < 4; ++m) { const int r = u.x * 256 + 128 * ai + 64 * wr + 16 * m + fr; const float rs = rsv[m];
                const size_t off = (size_t)r * 2048 + u.y * 128 + 32 * wc + 8 * fq; f32x4 a0, a1, b0, b1; unpk8(av[m], a0, a1); unpk8(bv[m], b0, b1);
#pragma unroll
                for (int j = 0; j < 4; ++j) { a0[j] = sigm(acc[ai][0][m][0][j] * rs) * a0[j] + sigm(acc[ai][1][m][0][j] * rs) * b0[j]; a1[j] = sigm(acc[ai][0][m][1][j] * rs) * a1[j] + sigm(acc[ai][1][m][1][j] * rs) * b1[j]; }
                *(u32x4*)(YA + off) = pk8(a0, a1); }
            asm volatile("" ::: "memory");
        }
    }
};
struct JobXs {
    int nt, lda, ldb, nunits; const bf16_t* XQ; const bf16_t* KM; bf16_t* P; int base;
    __device__ __forceinline__ void get(int L0, Unit& u, const char*& uA, const char*& uB) const { const int L = L0 + base, bh = L >> 4, qt = L & 15, b = bh >> 2, h = bh & 3;
        uA = (const char*)(XQ + (size_t)(b * 4096 + qt * 256) * 2048 + h * 512); uB = (const char*)(KM + (size_t)(b * 256) * 2048 + h * 512); u.x = L; u.y = 0; u.z = 0; }
    __device__ __forceinline__ void epi_drain(Acc& acc, const Unit& u, LAS unsigned char* lds, int wr, int wc, int fr, int fq) const {
        LAS float* MX = (LAS float*)lds; LAS float* SM = MX + 1024;
#pragma unroll
        for (int ai = 0; ai < 2; ++ai)
#pragma unroll
            for (int m = 0; m < 4; ++m) { float mx = -3.0e38f;
#pragma unroll
                for (int bj = 0; bj < 2; ++bj)
#pragma unroll
                    for (int n = 0; n < 2; ++n) { const f32x4 v = acc[ai][bj][m][n]; mx = fmaxf(mx, fmaxf(fmaxf(v[0], v[1]), fmaxf(v[2], v[3]))); }
                mx = fmaxf(mx, __shfl_xor(mx, 16)); mx = fmaxf(mx, __shfl_xor(mx, 32));
                if (fq == 0) MX[(128 * ai + 64 * wr + 16 * m + fr) * 4 + wc] = mx; }
        asm volatile("s_waitcnt lgkmcnt(0)" ::: "memory"); __syncthreads();
#pragma unroll
        for (int ai = 0; ai < 2; ++ai)
#pragma unroll
            for (int m = 0; m < 4; ++m) { const int row = 128 * ai + 64 * wr + 16 * m + fr; const f32x4 q = *(const LAS f32x4*)(MX + row * 4);
                const float mx = fmaxf(fmaxf(q[0], q[1]), fmaxf(q[2], q[3])); float s = 0.f;
#pragma unroll
                for (int bj = 0; bj < 2; ++bj)
#pragma unroll
                    for (int n = 0; n < 2; ++n) { f32x4 v = acc[ai][bj][m][n];
#pragma unroll
                        for (int j = 0; j < 4; ++j) v[j] = __expf(v[j] - mx);
                        acc[ai][bj][m][n] = v; s += (v[0] + v[1]) + (v[2] + v[3]); }
                s += __shfl_xor(s, 16); s += __shfl_xor(s, 32);
                if (fq == 0) SM[row * 4 + wc] = s; }
        asm volatile("s_waitcnt lgkmcnt(0)" ::: "memory"); __syncthreads();
#pragma unroll
        for (int ai = 0; ai < 2; ++ai)
#pragma unroll
            for (int m = 0; m < 4; ++m) { const int row = 128 * ai + 64 * wr + 16 * m + fr; const f32x4 q = *(const LAS f32x4*)(SM + row * 4);
                const float inv = 1.0f / ((q[0] + q[1]) + (q[2] + q[3])); bf16_t* rowp = P + ((size_t)u.x * 256 + row) * 256 + 32 * wc + 8 * fq;
#pragma unroll
                for (int bj = 0; bj < 2; ++bj) *(u32x4*)(rowp + 128 * bj) = pk8(acc[ai][bj][m][0] * inv, acc[ai][bj][m][1] * inv); }
        __syncthreads();
    }
};
template <> struct job_drain<JobXs> { static constexpr bool v = true; };
struct JobPv {
    int nt, lda, ldb, nunits; const bf16_t* P; const bf16_t* VT; bf16_t* XO;
    __device__ __forceinline__ void get(int L, Unit& u, const char*& uA, const char*& uB) const { const int bhq = L >> 1, et = L & 1, bh = bhq >> 4, b = bh >> 2, h = bh & 3;
        uA = (const char*)(P + (size_t)bhq * 256 * 256); uB = (const char*)(VT + ((size_t)b * 2048 + h * 512 + et * 256) * 256); u.x = bhq; u.y = et; u.z = 0; }
    __device__ __forceinline__ void epi(Acc& acc, const Unit& u, int wr, int wc, int fr, int fq) const { const int bh = u.x >> 4, qt = u.x & 15, b = bh >> 2, h = bh & 3;
        store_tile_bf16(acc, XO + (size_t)(b * 4096 + qt * 256) * 2048 + h * 512 + u.y * 256, 2048, wr, wc, fr, fq, 1.0f); }
};

__device__ __forceinline__ void transpose_item(const float* W, int K, int N, bf16_t* WT, int mode, const float* gain, LAS float* scr, int item, int lane) {
    const int nblk = N / 64, kb = item / nblk, nb = item % nblk, k0 = 64 * kb, n0 = 64 * nb;
    const int ro = lane >> 4, c4 = (lane & 15) * 4;
    f32x4 v[16];
#pragma unroll
    for (int i = 0; i < 16; ++i) v[i] = *(const f32x4*)(W + (size_t)(k0 + 4 * i + ro) * N + n0 + c4);
#pragma unroll
    for (int i = 0; i < 16; ++i) { const float g = gain ? gain[k0 + 4 * i + ro] : 1.0f; LAS float* s = scr + (4 * i + ro) * 65 + c4; s[0] = v[i][0] * g; s[1] = v[i][1] * g; s[2] = v[i][2] * g; s[3] = v[i][3] * g; }
    asm volatile("s_waitcnt lgkmcnt(0)" ::: "memory");
    const int c = lane & 7; int d0 = mode == 0 ? n0 : ((n0 >> 7) * 256 + (mode == 2 ? 128 : 0) + (n0 & 127));
    if (mode == 4) { if (n0 < 7168) d0 = n0; else { const int jg = (n0 - 7168) & 2047, sel = (n0 - 7168) >> 11; d0 = 7168 + (jg >> 7) * 256 + sel * 128 + (jg & 127); } }
#pragma unroll
    for (int j = 0; j < 8; ++j) { const int n = (lane >> 3) + 8 * j; const LAS float* s = scr + (8 * c) * 65 + n;
        u32x4 o; o.x = pk2(s[0 * 65], s[1 * 65]); o.y = pk2(s[2 * 65], s[3 * 65]); o.z = pk2(s[4 * 65], s[5 * 65]); o.w = pk2(s[6 * 65], s[7 * 65]);
        *(u32x4*)(WT + (size_t)(d0 + n) * K + k0 + 8 * c) = o; }
    asm volatile("s_waitcnt lgkmcnt(0)" ::: "memory");
}
#define TMAT(Wp, Kd, Nd, WTp, mode, gainp) { const int ni_ = ((Kd) / 64) * ((Nd) / 64); if (r < ni_) { transpose_item(Wp, Kd, Nd, WTp, mode, gainp, scr, r, lane); continue; } r -= ni_; }

__device__ __forceinline__ float row_sumsq_load(const float* xrow, int lane, f32x4 (&v)[8]) {
    float s = 0.f;
#pragma unroll
    for (int j = 0; j < 8; ++j) { v[j] = *(const f32x4*)(xrow + 4 * (lane + 64 * j)); s += (v[j][0] * v[j][0] + v[j][1] * v[j][1]) + (v[j][2] * v[j][2] + v[j][3] * v[j][3]); }
    return wave_sum(s);
}

__device__ __forceinline__ void s5_prep_item(const Params& p, LAS float* L, int g, int part, int tid) {
    LAS float* POWr = L; LAS float* POWi = L + 1088; LAS float* BBr = L + 2176; LAS float* BBi = L + 3200; LAS float* CCr = L + 4224; LAS float* CCi = L + 5248; LAS float* KL = L + 6272;
    const double dt = exp((double)p.in[I_LDT][g]);
    for (int idx = tid; idx < 64 * 17; idx += NTHR) { const int pp = idx / 17, tau = idx % 17; const double ar = p.in[I_ARE][g * 64 + pp], ai = p.in[I_AIM][g * 64 + pp];
        const double mag = exp(ar * dt * tau), ang = ai * dt * tau; POWr[idx] = (float)(mag * cos(ang)); POWi[idx] = (float)(mag * sin(ang)); }
    for (int idx = tid; idx < 64 * 16; idx += NTHR) { const int pp = idx >> 4; const double ar = p.in[I_ARE][g * 64 + pp], ai = p.in[I_AIM][g * 64 + pp];
        const double mag = exp(ar * dt), lre = mag * cos(ai * dt), lim = mag * sin(ai * dt), den = ar * ar + ai * ai, nr = lre - 1.0, ni = lim;
        const double fre = (nr * ar + ni * ai) / den, fim = (ni * ar - nr * ai) / den; const double br = p.in[I_BRE][(size_t)g * 1024 + idx], bi = p.in[I_BIM][(size_t)g * 1024 + idx];
        BBr[idx] = (float)(fre * br - fim * bi); BBi[idx] = (float)(fre * bi + fim * br); }
    for (int idx = tid; idx < 1024; idx += NTHR) { CCr[idx] = p.in[I_CRE][(size_t)g * 1024 + idx]; CCi[idx] = p.in[I_CIM][(size_t)g * 1024 + idx]; }
    __syncthreads();
    { const int ci = tid & 15, ch = (tid >> 4) & 15, half = tid >> 8; float s[8];
#pragma unroll
      for (int k = 0; k < 8; ++k) s[k] = 0.f;
      for (int pp = 0; pp < 64; ++pp) { const float cr = CCr[ch * 64 + pp], cim = CCi[ch * 64 + pp], br = BBr[pp * 16 + ci], bi = BBi[pp * 16 + ci];
          const float er = cr * br - cim * bi, ei = cr * bi + cim * br;
#pragma unroll
          for (int k = 0; k < 8; ++k) s[k] += er * POWr[pp * 17 + 8 * half + k] - ei * POWi[pp * 17 + 8 * half + k]; }
#pragma unroll
      for (int k = 0; k < 8; ++k) KL[(8 * half + k) * 256 + ch * 16 + ci] = s[k]; }
    __syncthreads();
    bf16_t* BT2 = (bf16_t*)(p.ws + WS_BT2); bf16_t* MB = (bf16_t*)(p.ws + WS_MB);
    for (int idx = tid; idx < 64 * 192; idx += NTHR) { const int rr = idx / 192, kp = idx % 192, n = part * 64 + rr, t = n >> 4, ch = n & 15; float v[2];
#pragma unroll
        for (int q = 0; q < 2; ++q) { const int k = 2 * kp + q;
            if (k < 256) { const int j = k >> 4, ci = k & 15; float x = (t >= j) ? KL[((t - j) * 16 + ch) * 16 + ci] : 0.f; if (t == j && ch == ci) x += p.in[I_S5D][g * 16 + ch]; v[q] = x; }
            else { const int kk = k - 256, pp = kk & 63; const float pr = POWr[pp * 17 + t + 1], pi = POWi[pp * 17 + t + 1], cr = CCr[ch * 64 + pp], ci_ = CCi[ch * 64 + pp];
                v[q] = kk < 64 ? (cr * pr - ci_ * pi) : -(cr * pi + ci_ * pr); } }
        *(unsigned*)(BT2 + ((size_t)g * 256 + n) * 384 + 2 * kp) = pk2(v[0], v[1]); }
    for (int idx = tid; idx < 32 * 128; idx += NTHR) { const int rr = idx >> 7, kp = idx & 127, s = part * 32 + rr, pp = s & 63, im = s >> 6; float v[2];
#pragma unroll
        for (int q = 0; q < 2; ++q) { const int k = 2 * kp + q, j = k >> 4, ci = k & 15; const float pr = POWr[pp * 17 + 15 - j], pi = POWi[pp * 17 + 15 - j], br = BBr[pp * 16 + ci], bi = BBi[pp * 16 + ci];
            v[q] = im ? (pr * bi + pi * br) : (pr * br - pi * bi); }
        *(unsigned*)(MB + ((size_t)g * 128 + s) * 256 + 2 * kp) = pk2(v[0], v[1]); }
    if (part == 0) { float* L16 = (float*)(p.ws + WS_L16); for (int idx = tid; idx < 64; idx += NTHR) { L16[(g * 64 + idx) * 2] = POWr[idx * 17 + 16]; L16[(g * 64 + idx) * 2 + 1] = POWi[idx * 17 + 16]; } }
    __syncthreads();
}

__device__ __forceinline__ void convert_ffn(const Params& p, LAS unsigned char* lds, int iw1, int iw3, int iw2, int ign, int gw, int NGW, int wave, int lane) {
    LAS float* scr = (LAS float*)(lds + wave * 16640);
    bf16_t* W13 = (bf16_t*)(p.ws + WS_W13); bf16_t* W2 = (bf16_t*)(p.ws + WS_W2);
    constexpr int NI = 3 * (2048 / 64) * (5632 / 64);
    for (int it = gw; it < NI; it += NGW) { int r = it;
        TMAT(p.in[iw1], 2048, 5632, W13, 1, p.in[ign])
        TMAT(p.in[iw3], 2048, 5632, W13, 2, p.in[ign])
        TMAT(p.in[iw2], 5632, 2048, W2, 0, (const float*)nullptr)
    }
}

#define XB_TMO      128
#define XB_XCNT(j)  (256  + 64 * (j))
#define XB_XSUB(j)  (1280 + 64 * (j))
#define XB_XGEN(j)  (2304 + 64 * (j))
#define XB_TOP      3328
#define XB_TOPGEN   3392
#define XCD_BAR_WORDS 3456
#define XB_SPIN_CAP (1u << 20)
__device__ __forceinline__ unsigned xb_ld(unsigned* p)              { return __hip_atomic_load(p, __ATOMIC_RELAXED, __HIP_MEMORY_SCOPE_AGENT); }
__device__ __forceinline__ unsigned xb_add(unsigned* p, unsigned v) { return __hip_atomic_fetch_add(p, v, __ATOMIC_RELAXED, __HIP_MEMORY_SCOPE_AGENT); }
__device__ __forceinline__ unsigned xb_xcc_id() { return (unsigned)__builtin_amdgcn_s_getreg((3 << 11) | 20) & 0xFu; }
#define XB_SPIN(cond, bar) do { unsigned _sp = 0; while (cond) { __builtin_amdgcn_s_sleep(1); \
    if ((++_sp & 255u) == 0u) { if (xb_ld(&(bar)[XB_TMO])) break; if (_sp > XB_SPIN_CAP) { atomicAdd(&(bar)[XB_TMO], 1u); break; } } } } while (0)
__device__ __forceinline__ void xcd_barrier_complete(unsigned* bar, unsigned x, unsigned& nloc, unsigned& nx) {
    const unsigned G = gridDim.x;
    unsigned sum, cnt, mine, sp = 0u;
    for (;;) {
        sum = 0u; cnt = 0u; mine = 0u;
#pragma unroll
        for (unsigned j = 0; j < 16; ++j) { const unsigned c = xb_ld(&bar[XB_XCNT(j)]); sum += c; cnt += (c > 0u) ? 1u : 0u; mine = (j == x) ? c : mine; }
        if (sum == G) break;
        __builtin_amdgcn_s_sleep(1);
        if ((++sp & 255u) == 0u) { if (xb_ld(&bar[XB_TMO])) break; if (sp > XB_SPIN_CAP) { atomicAdd(&bar[XB_TMO], 1u); break; } }
    }
    nloc = mine > 0u ? mine : 1u; nx = cnt > 0u ? cnt : 1u;
}
__device__ __forceinline__ void xcd_barrier(unsigned* bar, volatile LAS unsigned* st) {
    asm volatile("s_waitcnt vmcnt(0)" ::: "memory");
    __syncthreads();
    if (threadIdx.x == 0) {
        const unsigned x = xb_xcc_id();
        __builtin_amdgcn_s_waitcnt(0);
        unsigned nloc = st[0], nx = st[1];
        if (nloc == 0u) { xcd_barrier_complete(bar, x, nloc, nx); st[0] = nloc; st[1] = nx; }
        const unsigned old = xb_add(&bar[XB_XSUB(x)], 1u);
        const unsigned gen = old / nloc;
        if (old + 1u == (gen + 1u) * nloc) {
            __builtin_amdgcn_fence(__ATOMIC_RELEASE, "agent");
            asm volatile("s_waitcnt vmcnt(0)" ::: "memory");
            const unsigned og = xb_add(&bar[XB_TOP], 1u);
            const unsigned tg = og / nx;
            if (og + 1u == (tg + 1u) * nx) xb_add(&bar[XB_TOPGEN], 1u);
            else XB_SPIN(xb_ld(&bar[XB_TOPGEN]) == tg, bar);
            __builtin_amdgcn_fence(__ATOMIC_ACQUIRE, "agent");
            xb_add(&bar[XB_XGEN(x)], 1u);
            asm volatile("s_waitcnt vmcnt(0)" ::: "memory");
        } else {
            XB_SPIN(xb_ld(&bar[XB_XGEN(x)]) == gen, bar);
            __builtin_amdgcn_fence(__ATOMIC_ACQUIRE, "agent");
            asm volatile("s_waitcnt vmcnt(0)" ::: "memory");
        }
    }
    __syncthreads();
}

__global__ void __launch_bounds__(NTHR, 2) mega(Params p) {
    extern __shared__ __attribute__((aligned(16))) unsigned char lds_raw[];
    LAS unsigned char* lds = (LAS unsigned char*)lds_raw;
    cg::grid_group grid = cg::this_grid();
    const int tid = threadIdx.x, lane = tid & 63, wave = __builtin_amdgcn_readfirstlane(tid >> 6);
    const int G = gridDim.x, gw = blockIdx.x * NWAVE + wave, NGW = G * NWAVE;
    const size_t gtid = (size_t)blockIdx.x * NTHR + tid, NGT = (size_t)G * NTHR;
    {
        unsigned* bar = (unsigned*)(p.ws + WS_BAR);
        if (blockIdx.x == 0) for (int i = tid; i < XCD_BAR_WORDS; i += NTHR) __hip_atomic_store(bar + i, 0u, __ATOMIC_RELAXED, __HIP_MEMORY_SCOPE_AGENT);
        if (tid < 4) ((LAS unsigned*)(lds + LDS_XB))[tid] = 0u;
        __syncthreads();
    }
#define GBAR() xcd_barrier((unsigned*)(p.ws + WS_BAR), (volatile LAS unsigned*)(lds + LDS_XB))
#define W13 ((bf16_t*)(p.ws + WS_W13))
#define W2 ((bf16_t*)(p.ws + WS_W2))
#define WIN ((bf16_t*)(p.ws + WS_WIN))
#define WGLU ((bf16_t*)(p.ws + WS_WGLU))
#define WORET ((bf16_t*)(p.ws + WS_WORET))
#define WOUT ((bf16_t*)(p.ws + WS_WOUT))
#define WQ ((bf16_t*)(p.ws + WS_WQ))
#define WXO ((bf16_t*)(p.ws + WS_WXO))
#define WK ((bf16_t*)(p.ws + WS_WK))
#define WV ((bf16_t*)(p.ws + WS_WV))
#define HB ((bf16_t*)(p.ws + WS_HB))
#define RSTD ((float*)(p.ws + WS_RSTD))
#define PSS ((float*)(p.ws + WS_PSS))
#define RC ((float*)(p.ws + WS_ROPE))
#define BT2 ((bf16_t*)(p.ws + WS_BT2))
#define MB ((bf16_t*)(p.ws + WS_MB))
#define L16 ((float*)(p.ws + WS_L16))
#define GNS ((float*)(p.ws + WS_GNS))
#define MEMN ((bf16_t*)(p.ws + WS_MEMN))
#define KM ((bf16_t*)(p.ws + WS_KM))
#define VT ((bf16_t*)(p.ws + WS_VT))
#define ACT ((bf16_t*)(p.ws + WS_ACT))
#define U2 ((bf16_t*)(p.ws + WS_U2))
#define ACAT ((bf16_t*)(p.ws + WS_ACAT))
#define KB ((bf16_t*)(p.ws + WS_K))
#define KZT ((bf16_t*)(p.ws + WS_KZT))
#define BCAT ((bf16_t*)(p.ws + WS_BCAT))
#define OB ((bf16_t*)(p.ws + WS_O))
#define YA ((bf16_t*)(p.ws + WS_YA))
#define YB ((bf16_t*)(p.ws + WS_YB))
#define XL ((float*)(p.ws + WS_XL))
#define YACT ((bf16_t*)(p.ws + WS_YACT))
#define XQ ((bf16_t*)(p.ws + WS_XQ))
#define SC ((float*)(p.ws + WS_SC))
#define PB ((bf16_t*)(p.ws + WS_P))
#define XO ((bf16_t*)(p.ws + WS_XO))
#define RS (RC + 4096 * 128)
#define RCt (RC + 2 * 4096 * 128)
#define RSt (RC + 3 * 4096 * 128)
#define H (p.out)

    {
        for (size_t i = gtid; i < 128 * 256 / 2; i += NGT) ((unsigned*)(MB + (size_t)64 * 128 * 256))[i] = 0u;
        __syncthreads();
        for (size_t i = gtid; i < (size_t)4096 * 128; i += NGT) { const int l = (int)(i >> 7), k = (int)(i & 127);
            const float inv = powf(10000.0f, -(float)(2 * k) / 256.0f); const float ang = (float)l * inv; float cs, sn; sincosf(ang, &sn, &cs);
            RC[i] = cs; RS[i] = sn; RCt[(size_t)k * 4096 + l] = cs; RSt[(size_t)k * 4096 + l] = sn; }
        for (int row = gw; row < T; row += NGW) { f32x4 v[8]; const float ss = row_sumsq_load(p.in[I_X] + (size_t)row * DM, lane, v);
            if (lane == 0) RSTD[row] = rsqrtf(ss * (1.0f / DM) + 1e-6f);
#pragma unroll
            for (int j = 0; j < 8; ++j) { u32x2 w; w.x = pk2(v[j][0], v[j][1]); w.y = pk2(v[j][2], v[j][3]); *(u32x2*)(HB + (size_t)row * DM + 4 * (lane + 64 * j)) = w; } }
        for (int row = gw; row < NB * MEML; row += NGW) { f32x4 v[8]; const float ss = row_sumsq_load(p.in[I_MEM] + (size_t)row * DM, lane, v); const float rs = rsqrtf(ss * (1.0f / DM) + 1e-6f);
#pragma unroll
            for (int j = 0; j < 8; ++j) { const f32x4 gn = *(const f32x4*)(p.in[I_MEMNRM] + 4 * (lane + 64 * j)); u32x2 w; w.x = pk2(v[j][0] * rs * gn[0], v[j][1] * rs * gn[1]); w.y = pk2(v[j][2] * rs * gn[2], v[j][3] * rs * gn[3]);
                *(u32x2*)(MEMN + (size_t)row * DM + 4 * (lane + 64 * j)) = w; } }
        convert_ffn(p, lds, I_F1W1, I_F1W3, I_F1W2, I_FFN1N, gw, NGW, wave, lane);
        { LAS float* scr = (LAS float*)(lds + wave * 16640);
          constexpr int NI = (2048 / 64) * (11264 / 64) + 2 * (1024 / 64) * (2048 / 64) + 6 * (2048 / 64) * (2048 / 64);
          for (int it = gw; it < NI; it += NGW) { int r = it;
              TMAT(p.in[I_WIN], 2048, 11264, WIN, 4, p.in[I_MIXN])
              TMAT(p.in[I_GLUV], 1024, 2048, WGLU, 1, (const float*)nullptr)
              TMAT(p.in[I_GLUG], 1024, 2048, WGLU, 2, (const float*)nullptr)
              TMAT(p.in[I_RETWO], 2048, 2048, WORET, 0, (const float*)nullptr)
              TMAT(p.in[I_WOUT], 2048, 2048, WOUT, 0, (const float*)nullptr)
              TMAT(p.in[I_XWQ], 2048, 2048, WQ, 0, p.in[I_XN])
              TMAT(p.in[I_XWK], 2048, 2048, WK, 0, (const float*)nullptr)
              TMAT(p.in[I_XWV], 2048, 2048, WV, 0, (const float*)nullptr)
              TMAT(p.in[I_XWO], 2048, 2048, WXO, 0, (const float*)nullptr)
          } }
        __syncthreads();
    }
    grid.sync();
    if (tid == 0) (void)xb_add(&((unsigned*)(p.ws + WS_BAR))[XB_XCNT(xb_xcc_id())], 1u);
    { JobFfnUp J{32, 2048, 2048, 2880, HB, W13, RSTD, ACT, MEMN, WK, WV, KM, VT}; gemm_phase(lds, J); }
    if (G == 256) { if (blockIdx.x >= 64) for (int it = blockIdx.x - 64; it < 256; it += 192) s5_prep_item(p, (LAS float*)lds, it & 63, it >> 6, tid); }
    else { for (int it = blockIdx.x; it < 256; it += G) s5_prep_item(p, (LAS float*)lds, it & 63, it >> 6, tid); }
    GBAR();
    { JobRes J{88, 5632, 5632, 512, ACT, W2, HB, PSS, 0.5f}; gemm_phase(lds, J, true); }
    GBAR();
    if (G == 256) {
        unsigned t0 = (unsigned)tid; asm volatile("" : "+v"(t0));
        if (t0 < 256u) { const unsigned r = (unsigned)(8 * (blockIdx.x & 7) + ((blockIdx.x >> 3) & 7)) * 256u + t0; float s = 0.f;
#pragma unroll
            for (int j = 0; j < 8; ++j) { const f32x4 v = *(const f32x4*)(PSS + (size_t)r * 32 + 4 * j); s += (v[0] + v[1]) + (v[2] + v[3]); }
            RSTD[r] = rsqrtf(s * (1.0f / DM) + 1e-6f); }
        asm volatile("s_waitcnt vmcnt(0)" ::: "memory"); __syncthreads();
    } else {
    { unsigned r0 = (unsigned)blockIdx.x * NTHR + (unsigned)tid; asm volatile("" : "+v"(r0));
      for (unsigned r = r0; r < (unsigned)T; r += (unsigned)G * NTHR) { float s = 0.f;
#pragma unroll
        for (int j = 0; j < 8; ++j) { const f32x4 v = *(const f32x4*)(PSS + (size_t)r * 32 + 4 * j); s += (v[0] + v[1]) + (v[2] + v[3]); }
        RSTD[r] = rsqrtf(s * (1.0f / DM) + 1e-6f); } }
        GBAR();
    }
    { JobWin1 J{32, 2048, 2048, 1280, HB, WIN, RSTD, RC, RS, RCt, RSt, U2, ACAT, KB, KZT, BCAT}; gemm_phase(lds, J, true); }
    GBAR();
    { JobScores J{4, 512, 1024, 256, ACAT, KB}; gemm_phase(lds, J); }
    { JobKV J{4, 512, 4096, 512, BCAT, KZT}; gemm_phase(lds, J); }
    { JobS5P1 J{4, 384, 256, 256, U2, MB, XL}; gemm_phase(lds, J); }
    GBAR();
    {
        for (int it = blockIdx.x; it < 256; it += G) { const int b = it >> 6, g = it & 63; const float ar = L16[(g * 64 + lane) * 2], ai = L16[(g * 64 + lane) * 2 + 1];
            const float* xl = XL + ((size_t)g * 1024 + b * 256 + 32 * wave) * 128 + lane; float lr[32], li[32], er[32], ei[32];
#pragma unroll
            for (int k = 0; k < 32; ++k) { lr[k] = xl[(size_t)k * 128]; li[k] = xl[(size_t)k * 128 + 64]; }
            float xr = 0.f, xi = 0.f;
#pragma unroll
            for (int k = 0; k < 32; ++k) { er[k] = xr; ei[k] = xi; const float nr = ar * xr - ai * xi + lr[k], ni = ar * xi + ai * xr + li[k]; xr = nr; xi = ni; }
            LAS float* sh = (LAS float*)lds; sh[(wave * 64 + lane) * 2] = xr; sh[(wave * 64 + lane) * 2 + 1] = xi;
            float qr = ar, qi = ai;
#pragma unroll
            for (int k = 0; k < 5; ++k) { const float t = qr * qr - qi * qi; qi = 2.f * qr * qi; qr = t; }
            __syncthreads();
            float cr = 0.f, ci = 0.f;
            for (int w2 = 0; w2 < wave; ++w2) { const float e0 = sh[(w2 * 64 + lane) * 2], e1 = sh[(w2 * 64 + lane) * 2 + 1]; const float t = qr * cr - qi * ci + e0; ci = qr * ci + qi * cr + e1; cr = t; }
            bf16_t* up = U2 + ((size_t)g * 1024 + b * 256 + 32 * wave) * 384 + 256 + lane; float pr = 1.f, pi = 0.f;
#pragma unroll
            for (int k = 0; k < 32; ++k) { const float vr = pr * cr - pi * ci + er[k], vi = pr * ci + pi * cr + ei[k];
                up[(size_t)k * 384] = (bf16_t)(pk2(vr, 0.f) & 0xffffu); up[(size_t)k * 384 + 64] = (bf16_t)(pk2(vi, 0.f) & 0xffffu);
                const float t = pr * ar - pi * ai; pi = pr * ai + pi * ar; pr = t; }
            __syncthreads();
        }
        for (size_t it = gtid; it < (size_t)16 * 512 * 32; it += NGT) { const int d8 = (int)(it & 31), e = (int)((it >> 5) & 511), bh = (int)(it >> 14);
            const float g256 = exp2f(256.0f * lgam(bh & 3)); f32x4 s0 = {0.f, 0.f, 0.f, 0.f}, s1 = s0;
            bf16_t* ptr = BCAT + ((size_t)(bh * 16) * 512 + e) * 512 + 256 + d8 * 8; u32x4 v[16];
#pragma unroll
            for (int c = 0; c < 16; ++c) v[c] = *(const u32x4*)(ptr + (size_t)c * 512 * 512);
#pragma unroll
            for (int c = 0; c < 16; ++c) { f32x4 a0, a1; unpk8(v[c], a0, a1); *(u32x4*)(ptr + (size_t)c * 512 * 512) = pk8(s0, s1); s0 = s0 * g256 + a0; s1 = s1 * g256 + a1; } }
    }
    GBAR();
    { JobRetOut J{8, 512, 512, 512, ACAT, BCAT, OB, (float*)(p.ws + WS_GNP)}; gemm_phase(lds, J); }
    { JobS5P2 J{6, 384, 384, 256, U2, BT2, YACT}; gemm_phase(lds, J); }
    GBAR();
    { JobGret J{32, 2048, 2048, 512, HB, WIN + (size_t)5120 * 2048, RSTD, (const float*)(p.ws + WS_GNP), OB}; gemm_phase(lds, J); }
    { JobGlu J{16, 1024, 1024, 1024, YACT, WGLU, YA}; gemm_phase(lds, J); }
    GBAR();
    { JobPlain J{32, 2048, 2048, 512, OB, WORET, YB, nullptr, 1.0f}; gemm_phase(lds, J); }
    if (G != 256) GBAR();
    { JobGate2 J{32, 2048, 2048, 1024, HB, WIN + (size_t)7168 * 2048, RSTD, YA, YB, G == 256 ? 1 : 0}; gemm_phase(lds, J); }
    GBAR();
    { JobRes J{32, 2048, 2048, 512, YA, WOUT, HB, PSS, 1.0f}; gemm_phase(lds, J, true); }
    GBAR();
    convert_ffn(p, lds, I_F2W1, I_F2W3, I_F2W2, I_FFN2N, gw, NGW, wave, lane);
    __syncthreads();
    if (G == 256) {
        unsigned t0 = (unsigned)tid; asm volatile("" : "+v"(t0));
        if (t0 < 256u) { const unsigned r = (unsigned)(8 * (blockIdx.x & 7) + ((blockIdx.x >> 3) & 7)) * 256u + t0; float s = 0.f;
#pragma unroll
            for (int j = 0; j < 8; ++j) { const f32x4 v = *(const f32x4*)(PSS + (size_t)r * 32 + 4 * j); s += (v[0] + v[1]) + (v[2] + v[3]); }
            RSTD[r] = rsqrtf(s * (1.0f / DM) + 1e-6f); }
        asm volatile("s_waitcnt vmcnt(0)" ::: "memory"); __syncthreads();
    } else {
    { unsigned r0 = (unsigned)blockIdx.x * NTHR + (unsigned)tid; asm volatile("" : "+v"(r0));
      for (unsigned r = r0; r < (unsigned)T; r += (unsigned)G * NTHR) { float s = 0.f;
#pragma unroll
        for (int j = 0; j < 8; ++j) { const f32x4 v = *(const f32x4*)(PSS + (size_t)r * 32 + 4 * j); s += (v[0] + v[1]) + (v[2] + v[3]); }
        RSTD[r] = rsqrtf(s * (1.0f / DM) + 1e-6f); } }
        GBAR();
    }
    { JobPlain J{32, 2048, 2048, 512, HB, WQ, XQ, RSTD, 0.04419417382415922f}; gemm_phase(lds, J, true); }
    GBAR();
    for (int base = 0; base < 256; base += G) { JobXs J{8, 2048, 2048, (256 - base) < G ? (256 - base) : G, XQ, KM, PB, base}; gemm_phase(lds, J); }
    GBAR();
    { JobPv J{4, 256, 256, 512, PB, VT, XO}; gemm_phase(lds, J); }
    GBAR();
    { JobRes J{32, 2048, 2048, 512, XO, WXO, HB, PSS, 1.0f}; gemm_phase(lds, J); }
    GBAR();
    if (G == 256) {
        unsigned t0 = (unsigned)tid; asm volatile("" : "+v"(t0));
        if (t0 < 256u) { const unsigned r = (unsigned)(8 * (blockIdx.x & 7) + ((blockIdx.x >> 3) & 7)) * 256u + t0; float s = 0.f;
#pragma unroll
            for (int j = 0; j < 8; ++j) { const f32x4 v = *(const f32x4*)(PSS + (size_t)r * 32 + 4 * j); s += (v[0] + v[1]) + (v[2] + v[3]); }
            RSTD[r] = rsqrtf(s * (1.0f / DM) + 1e-6f); }
        asm volatile("s_waitcnt vmcnt(0)" ::: "memory"); __syncthreads();
    } else {
    { unsigned r0 = (unsigned)blockIdx.x * NTHR + (unsigned)tid; asm volatile("" : "+v"(r0));
      for (unsigned r = r0; r < (unsigned)T; r += (unsigned)G * NTHR) { float s = 0.f;
#pragma unroll
        for (int j = 0; j < 8; ++j) { const f32x4 v = *(const f32x4*)(PSS + (size_t)r * 32 + 4 * j); s += (v[0] + v[1]) + (v[2] + v[3]); }
        RSTD[r] = rsqrtf(s * (1.0f / DM) + 1e-6f); } }
        GBAR();
    }
    { JobFfnUp J{32, 2048, 2048, 2816, HB, W13, RSTD, ACT, MEMN, WK, WV, KM, VT}; gemm_phase(lds, J, true); }
    GBAR();
    { JobRes J{88, 5632, 5632, 512, ACT, W2, HB, nullptr, 0.5f}; gemm_phase(lds, J, true); }
    GBAR();
    for (int row = gw; row < T; row += NGW) { f32x4 v[8]; float s = 0.f;
#pragma unroll
        for (int j = 0; j < 4; ++j) { unpk8(*(const u32x4*)(HB + (size_t)row * DM + 8 * (lane + 64 * j)), v[2 * j], v[2 * j + 1]);
            s += (v[2 * j][0] * v[2 * j][0] + v[2 * j][1] * v[2 * j][1]) + (v[2 * j][2] * v[2 * j][2] + v[2 * j][3] * v[2 * j][3]) + (v[2 * j + 1][0] * v[2 * j + 1][0] + v[2 * j + 1][1] * v[2 * j + 1][1]) + (v[2 * j + 1][2] * v[2 * j + 1][2] + v[2 * j + 1][3] * v[2 * j + 1][3]); }
        const float rs = rsqrtf(wave_sum(s) * (1.0f / DM) + 1e-6f);
#pragma unroll
        for (int j = 0; j < 4; ++j) { const int c0 = 8 * (lane + 64 * j); const f32x4 g0 = *(const f32x4*)(p.in[I_FINALN] + c0), g1 = *(const f32x4*)(p.in[I_FINALN] + c0 + 4);
            *(f32x4*)(H + (size_t)row * DM + c0) = v[2 * j] * rs * g0; *(f32x4*)(H + (size_t)row * DM + c0 + 4) = v[2 * j + 1] * rs * g1; } }
}

extern "C" void kernel_launch(void* const* d_in, const int* in_sizes, int n_in, void* d_out, int out_size, void* d_ws, size_t ws_size, hipStream_t stream) {
    static int grid = 0;
    if (grid == 0) {
        if (n_in != 31 || out_size != T * DM || ws_size < WS_END) { fprintf(stderr, "kernel_launch: unexpected problem (n_in %d, out %d, ws %zu < %zu)\n", n_in, out_size, ws_size, (size_t)WS_END); grid = -1; return; }
        int dev = 0, cus = 0, per_cu = 0;
        hipGetDevice(&dev); hipDeviceGetAttribute(&cus, hipDeviceAttributeMultiprocessorCount, dev);
        if (hipFuncSetAttribute((const void*)mega, hipFuncAttributeMaxDynamicSharedMemorySize, LDS_BYTES) != hipSuccess) { fprintf(stderr, "kernel_launch: hipFuncSetAttribute failed\n"); grid = -1; return; }
        if (hipOccupancyMaxActiveBlocksPerMultiprocessor(&per_cu, (const void*)mega, NTHR, LDS_BYTES) != hipSuccess || per_cu < 1) { fprintf(stderr, "kernel_launch: occupancy query says %d\n", per_cu); per_cu = 1; }
        (void)hipGetLastError();
        grid = cus * per_cu; if (grid > 256) grid = 256;
        fprintf(stderr, "kernel_launch: grid %d (cus %d x %d)\n", grid, cus, per_cu);
    }
    if (grid < 0) return;
    Params p{};
    for (int i = 0; i < 31; ++i) p.in[i] = (const float*)d_in[i];
    p.out = (float*)d_out; p.ws = (unsigned char*)d_ws;
    void* args[] = {&p};
    hipError_t e = hipLaunchCooperativeKernel((const void*)mega, dim3(grid), dim3(NTHR), args, LDS_BYTES, stream);
    if (e != hipSuccess) fprintf(stderr, "kernel_launch: cooperative launch failed: %s\n", hipGetErrorString(e));
}
```
